# Optimizing an MI355X kernel written in HIP

```python
import jax, jax.numpy as jnp
from jax import lax
import numpy as np

D_MODEL = 2048
BATCH = 4
SEQ = 4096
DEPTH = 2

GRID_W = 64
CTX_LEN = 256
EPS = 1e-6
ROPE_THETA = 10000.0

HGRN_DK = 128
HGRN_DV = 128
HGRN_HEADS = (D_MODEL // 2) // HGRN_DK
HGRN_CHUNK = 64
WIN_HEAD_DIM = 64
WIN_HEADS = (D_MODEL // 2) // WIN_HEAD_DIM
WIN_KV_HEADS = 2
WINDOW = 128
WIN_BLOCK = 128
GLB_HEAD_DIM = 128
GLB_HEADS = D_MODEL // GLB_HEAD_DIM
GLB_KV_HEADS = GLB_HEADS // 4
Q_BLOCK = 128
N_EXPERTS = 64
N_GROUPS = 8
TOPK_GROUPS = 4
TOP_K = 8
D_EXPERT = D_MODEL // 4
D_SHARED = D_MODEL // 4
ROUTED_SCALE = 2.5
MOE_BLOCK = 256

A_K = HGRN_HEADS * HGRN_DK
A_V = HGRN_HEADS * HGRN_DV
B_Q = WIN_HEADS * WIN_HEAD_DIM
B_KV = WIN_KV_HEADS * WIN_HEAD_DIM
EVEN_SPLITS = (A_K, A_K + A_V, 2 * A_K + A_V, 3 * A_K + A_V, 3 * A_K + 2 * A_V,
               3 * A_K + 2 * A_V + B_Q, 3 * A_K + 2 * A_V + B_Q + B_KV)
EVEN_IN = 3 * A_K + 2 * A_V + B_Q + 2 * B_KV
EVEN_OUT_IN = A_V + B_Q
C_Q = GLB_HEADS * GLB_HEAD_DIM
C_KV = GLB_KV_HEADS * GLB_HEAD_DIM
ODD_SPLITS = (C_Q, C_Q + C_KV)
ODD_IN = C_Q + 2 * C_KV

kernel_name = 'hybrid_flow_hgrn2_swa_gqa_moe'

f32 = jnp.float32


def rms_norm(x, g):
    xf = x.astype(f32)
    y = xf * lax.rsqrt(jnp.mean(xf * xf, axis=-1, keepdims=True) + EPS)
    return y.astype(x.dtype) * g


def axial_rope(x, rows, cols):
    L = x.shape[1]
    half = x.shape[-1] // 2
    xf = x.astype(f32)

    def rot(xp, pos):
        m = xp.shape[-1]
        freqs = ROPE_THETA ** (-jnp.arange(0, m, 2, dtype=f32) / m)
        ang = pos.astype(f32)[:, None] * freqs[None, :]
        shape = (1, L) + (1,) * (x.ndim - 3) + (m // 2,)
        cos = jnp.cos(ang).reshape(shape)
        sin = jnp.sin(ang).reshape(shape)
        x1, x2 = xp[..., :m // 2], xp[..., m // 2:]
        return jnp.concatenate([x1 * cos - x2 * sin, x2 * cos + x1 * sin], axis=-1)

    out = jnp.concatenate([rot(xf[..., :half], rows), rot(xf[..., half:], cols)], axis=-1)
    return out.astype(x.dtype)


def dense_attention(q, k, v, sink=None):
    B, Lq, KV, G, Dh = q.shape
    Lk = k.shape[1]
    s = jnp.einsum('bqkgd,bskd->bkgqs', q, k).astype(f32) * Dh ** -0.5
    if sink is not None:
        sk = jnp.broadcast_to(sink.astype(f32).reshape(1, KV, G, 1, 1), s.shape[:-1] + (1,))
        s = jnp.concatenate([s, sk], axis=-1)
    p = jax.nn.softmax(s, axis=-1)[..., :Lk].astype(v.dtype)
    return jnp.einsum('bkgqs,bskd->bqkgd', p, v).reshape(B, Lq, KV * G * Dh)


def window_attention(q, k, v, kc, vc, sink):
    B, L, KV, G, Dh = q.shape
    W = WIN_BLOCK
    nb = L // W
    scale = Dh ** -0.5
    pad = ((0, 0), (W, W), (0, 0), (0, 0))
    kp = jnp.pad(k, pad).reshape(B, nb + 2, W, KV, Dh)
    vp = jnp.pad(v, pad).reshape(B, nb + 2, W, KV, Dh)
    kw = jnp.concatenate([kp[:, :-2], kp[:, 1:-1], kp[:, 2:]], axis=2)
    vw = jnp.concatenate([vp[:, :-2], vp[:, 1:-1], vp[:, 2:]], axis=2)
    qb = q.reshape(B, nb, W, KV, G, Dh)
    qpos = jnp.arange(nb)[:, None, None] * W + jnp.arange(W)[None, :, None]
    kpos = (jnp.arange(nb)[:, None, None] - 1) * W + jnp.arange(3 * W)[None, None, :]
    valid = (jnp.abs(kpos - qpos) <= WINDOW) & (kpos >= 0) & (kpos < L)
    s_win = jnp.einsum('bnqkgd,bnskd->bnkgqs', qb, kw).astype(f32) * scale
    s_win = jnp.where(valid[None, :, None, None], s_win, -jnp.inf)
    s_ctx = jnp.einsum('bnqkgd,bckd->bnkgqc', qb, kc).astype(f32) * scale
    s_sink = jnp.broadcast_to(sink.astype(f32).reshape(1, 1, KV, G, 1, 1), s_win.shape[:-1] + (1,))
    p = jax.nn.softmax(jnp.concatenate([s_win, s_ctx, s_sink], axis=-1), axis=-1).astype(v.dtype)
    n_win = 3 * W
    n_ctx = kc.shape[1]
    out = (jnp.einsum('bnkgqs,bnskd->bnqkgd', p[..., :n_win], vw)
           + jnp.einsum('bnkgqc,bckd->bnqkgd', p[..., n_win:n_win + n_ctx], vc))
    return out.reshape(B, L, KV * G * Dh)


def global_attention(q, k, v):
    B, L, KV, G, Dh = q.shape
    nb = L // Q_BLOCK
    qb = q.reshape(B, nb, Q_BLOCK, KV, G, Dh).transpose(1, 0, 2, 3, 4, 5)

    def block(qi):
        s = jnp.einsum('bqkgd,bskd->bkgqs', qi, k).astype(f32) * Dh ** -0.5
        p = jax.nn.softmax(s, axis=-1).astype(v.dtype)
        return jnp.einsum('bkgqs,bskd->bqkgd', p, v)

    out = lax.map(block, qb)
    return out.transpose(1, 0, 2, 3, 4, 5).reshape(B, L, KV * G * Dh)


def gla_chunked(q, k, v, log_f, s0):
    B, L, H, DK = q.shape
    DV = v.shape[-1]
    n = L // HGRN_CHUNK

    def to_chunks(t):
        return t.reshape(B, n, HGRN_CHUNK, H, t.shape[-1]).transpose(1, 0, 3, 2, 4)

    tri = jnp.tril(jnp.ones((HGRN_CHUNK, HGRN_CHUNK), bool))[None, None, :, :, None]

    def step(S, inp):
        qb, kb, vb, gb = inp
        b = jnp.cumsum(gb, axis=2)
        o_inter = jnp.einsum('bhtk,bhkv->bhtv', qb * jnp.exp(b), S)
        decay = jnp.exp(jnp.where(tri, b[:, :, :, None, :] - b[:, :, None, :, :], -jnp.inf))
        att = jnp.einsum('bhtsk,bhsk->bhts', qb[:, :, :, None, :] * decay, kb)
        o_intra = jnp.einsum('bhts,bhsv->bhtv', att, vb)
        b_last = b[:, :, -1:, :]
        S_new = (jnp.exp(b_last[:, :, 0, :])[..., None] * S
                 + jnp.einsum('bhsk,bhsv->bhkv', kb * jnp.exp(b_last - b), vb))
        return S_new, o_inter + o_intra

    s_final, o = lax.scan(step, s0, tuple(to_chunks(t) for t in (q, k, v, log_f)))
    return o.transpose(1, 0, 3, 2, 4).reshape(B, L, H, DV), s_final


def hgrn_prep(q, v, f_fwd, f_bwd, lb):
    B, n, _ = q.shape

    def heads(t, d):
        return t.astype(f32).reshape(B, n, HGRN_HEADS, d)

    def forget(f_raw):
        f = lb + (1.0 - lb) * jax.nn.sigmoid(f_raw.astype(f32))
        return heads(1.0 - f, HGRN_DK), heads(jnp.log(f), HGRN_DK)

    return heads(jax.nn.silu(q.astype(f32)), HGRN_DK), heads(v, HGRN_DV), forget(f_fwd), forget(f_bwd)


def hgrn_out(o, g, gain):
    B, n, H, DV = o.shape
    o = o * lax.rsqrt(jnp.mean(o * o, axis=-1, keepdims=True) + EPS) * gain.astype(f32)
    o = o * jax.nn.silu(g.astype(f32).reshape(B, n, H, DV))
    return o.reshape(B, n, H * DV).astype(g.dtype)


def even_mixer(h, hc, w_in, w_out, lb, g_onorm, sink, rows, cols, need_ctx):
    B, L, _ = h.shape
    Lc = hc.shape[1]
    G = WIN_HEADS // WIN_KV_HEADS
    q_a, i_a, ff_a, fb_a, g_a, q_b, k_b, v_b = jnp.split(h @ w_in, EVEN_SPLITS, axis=-1)
    cq_a, ci_a, cff_a, cfb_a, cg_a, cq_b, ck_b, cv_b = jnp.split(hc @ w_in, EVEN_SPLITS, axis=-1)

    ql, vl, (kfl, gfl), (kbl, gbl) = hgrn_prep(q_a, i_a, ff_a, fb_a, lb)
    qc, vc, (kfc, gfc), (kbc, gbc) = hgrn_prep(cq_a, ci_a, cff_a, cfb_a, lb)
    s0 = jnp.zeros((B, HGRN_HEADS, HGRN_DK, HGRN_DV), f32)
    oc_f, sc_f = gla_chunked(qc, kfc, vc, gfc, s0)
    oc_b, sc_b = gla_chunked(qc[:, ::-1], kbc[:, ::-1], vc[:, ::-1], gbc[:, ::-1], s0)
    ol_f, _ = gla_chunked(ql, kfl, vl, gfl, sc_f)
    ol_b, _ = gla_chunked(ql[:, ::-1], kbl[:, ::-1], vl[:, ::-1], gbl[:, ::-1], sc_b)
    a_lat = hgrn_out(ol_f + ol_b[:, ::-1], g_a, g_onorm)

    qb = axial_rope(q_b.reshape(B, L, WIN_HEADS, WIN_HEAD_DIM), rows, cols).reshape(B, L, WIN_KV_HEADS, G, WIN_HEAD_DIM)
    kb = axial_rope(k_b.reshape(B, L, WIN_KV_HEADS, WIN_HEAD_DIM), rows, cols)
    vb = v_b.reshape(B, L, WIN_KV_HEADS, WIN_HEAD_DIM)
    ckb = ck_b.reshape(B, Lc, WIN_KV_HEADS, WIN_HEAD_DIM)
    cvb = cv_b.reshape(B, Lc, WIN_KV_HEADS, WIN_HEAD_DIM)
    b_lat = window_attention(qb, kb, vb, ckb, cvb, sink)

    y = jnp.concatenate([a_lat, b_lat], axis=-1) @ w_out
    yc = None
    if need_ctx:
        a_ctx = hgrn_out(oc_f + oc_b[:, ::-1], cg_a, g_onorm)
        b_ctx = dense_attention(cq_b.reshape(B, Lc, WIN_KV_HEADS, G, WIN_HEAD_DIM), ckb, cvb, sink)
        yc = jnp.concatenate([a_ctx, b_ctx], axis=-1) @ w_out
    return y, yc


def odd_mixer(h, hc, w_in, w_out, gq, gk, rows, cols, need_ctx):
    B, L, _ = h.shape
    Lc = hc.shape[1]
    G = GLB_HEADS // GLB_KV_HEADS

    def qkv(t, n):
        q, k, v = jnp.split(t @ w_in, ODD_SPLITS, axis=-1)
        q = rms_norm(q.reshape(B, n, GLB_HEADS, GLB_HEAD_DIM), gq)
        k = rms_norm(k.reshape(B, n, GLB_KV_HEADS, GLB_HEAD_DIM), gk)
        return q, k, v.reshape(B, n, GLB_KV_HEADS, GLB_HEAD_DIM)

    q, k, v = qkv(h, L)
    cq, ck, cv = qkv(hc, Lc)
    q = axial_rope(q, rows, cols).reshape(B, L, GLB_KV_HEADS, G, GLB_HEAD_DIM)
    k = axial_rope(k, rows, cols)
    k_all = jnp.concatenate([ck, k], axis=1)
    v_all = jnp.concatenate([cv, v], axis=1)
    y = global_attention(q, k_all, v_all) @ w_out
    yc = None
    if need_ctx:
        yc = dense_attention(cq.reshape(B, Lc, GLB_KV_HEADS, G, GLB_HEAD_DIM), ck, cv) @ w_out
    return y, yc


def moe_ffn(h, w_router, b_router, w_gate, w_up, w_down, ws_gate, ws_up, ws_down):
    T, D = h.shape
    per_group = N_EXPERTS // N_GROUPS
    scores = jax.nn.sigmoid((h @ w_router).astype(f32))
    biased = scores + b_router.astype(f32)
    group_score = lax.top_k(biased.reshape(T, N_GROUPS, per_group), 2)[0].sum(-1)
    _, top_groups = lax.top_k(group_score, TOPK_GROUPS)
    group_mask = jnp.any(top_groups[:, :, None] == jnp.arange(N_GROUPS)[None, None, :], axis=1)
    expert_mask = jnp.repeat(group_mask, per_group, axis=1)
    _, idx = lax.top_k(jnp.where(expert_mask, biased, -jnp.inf), TOP_K)
    wts = jnp.take_along_axis(scores, idx, axis=1)
    wts = wts / jnp.sum(wts, axis=-1, keepdims=True) * ROUTED_SCALE

    n_assign = T * TOP_K
    flat_e = idx.reshape(-1)
    flat_tok = jnp.arange(n_assign, dtype=jnp.int32) // TOP_K
    order = jnp.argsort(flat_e)
    sorted_e = flat_e[order]
    counts = jnp.bincount(flat_e, length=N_EXPERTS)
    padded = (counts + MOE_BLOCK - 1) // MOE_BLOCK * MOE_BLOCK
    padded_end = jnp.cumsum(padded)
    start = jnp.cumsum(counts) - counts
    dest = (padded_end - padded)[sorted_e] + jnp.arange(n_assign) - start[sorted_e]
    n_blocks = (n_assign + N_EXPERTS * (MOE_BLOCK - 1) + MOE_BLOCK - 1) // MOE_BLOCK
    n_slots = n_blocks * MOE_BLOCK
    slot_tok = jnp.zeros((n_slots,), jnp.int32).at[dest].set(flat_tok[order])
    slot_w = jnp.zeros((n_slots,), f32).at[dest].set(wts.reshape(-1)[order])
    block_e = jnp.minimum(jnp.searchsorted(padded_end, jnp.arange(n_blocks) * MOE_BLOCK, side='right'), N_EXPERTS - 1)

    def expert_block(args):
        tok, wb, e = args
        xb = h[tok]
        hid = jax.nn.silu(xb @ w_gate[e]) * (xb @ w_up[e])
        return (hid @ w_down[e]) * wb[:, None].astype(h.dtype)

    y_slots = lax.map(expert_block, (slot_tok.reshape(n_blocks, MOE_BLOCK), slot_w.reshape(n_blocks, MOE_BLOCK), block_e))
    routed = jax.ops.segment_sum(y_slots.reshape(n_slots, D), slot_tok, num_segments=T)
    shared = (jax.nn.silu(h @ ws_gate) * (h @ ws_up)) @ ws_down
    return routed.astype(h.dtype) + shared


def setup_inputs(seed: int = 0) -> dict:
    key = jax.random.key(seed)
    ks = jax.random.split(key, 32)
    D = D_MODEL
    n_even = (DEPTH + 1) // 2
    n_odd = DEPTH // 2

    def nrm(k, shape, scale):
        return jax.random.normal(k, shape, f32) * scale

    return {
        'x': nrm(ks[0], (BATCH, SEQ, D), 1.0),
        'c': nrm(ks[1], (BATCH, D), 1.0),
        'ctx': nrm(ks[2], (BATCH, CTX_LEN, D), 1.0),
        'c_ctx': nrm(ks[3], (D,), 1.0),
        'w_ada': nrm(ks[4], (DEPTH, D, 6 * D), 0.5 * D ** -0.5),
        'b_ada': nrm(ks[5], (DEPTH, 6 * D), 0.01),
        'g_norm_mix': 1.0 + nrm(ks[6], (DEPTH, D), 0.02),
        'g_norm_ffn': 1.0 + nrm(ks[7], (DEPTH, D), 0.02),
        'w_in_even': nrm(ks[8], (n_even, D, EVEN_IN), D ** -0.5),
        'w_out_even': nrm(ks[9], (n_even, EVEN_OUT_IN, D), EVEN_OUT_IN ** -0.5),
        'hgrn_lb_logits': nrm(ks[10], (DEPTH + 1, A_K), 0.5),
        'g_hgrn_norm': 1.0 + nrm(ks[11], (n_even, HGRN_DV), 0.02),
        'win_sink': nrm(ks[12], (n_even, WIN_HEADS), 0.5),
        'w_in_odd': nrm(ks[13], (n_odd, D, ODD_IN), D ** -0.5),
        'w_out_odd': nrm(ks[14], (n_odd, C_Q, D), C_Q ** -0.5),
        'g_q_norm': 1.0 + nrm(ks[15], (n_odd, GLB_HEAD_DIM), 0.02),
        'g_k_norm': 1.0 + nrm(ks[16], (n_odd, GLB_HEAD_DIM), 0.02),
        'w_router': nrm(ks[17], (DEPTH, D, N_EXPERTS), D ** -0.5),
        'b_router': nrm(ks[18], (DEPTH, N_EXPERTS), 0.01),
        'w_exp_gate': nrm(ks[19], (DEPTH, N_EXPERTS, D, D_EXPERT), D ** -0.5),
        'w_exp_up': nrm(ks[20], (DEPTH, N_EXPERTS, D, D_EXPERT), D ** -0.5),
        'w_exp_down': nrm(ks[21], (DEPTH, N_EXPERTS, D_EXPERT, D), D_EXPERT ** -0.5),
        'w_sh_gate': nrm(ks[22], (DEPTH, D, D_SHARED), D ** -0.5),
        'w_sh_up': nrm(ks[23], (DEPTH, D, D_SHARED), D ** -0.5),
        'w_sh_down': nrm(ks[24], (DEPTH, D_SHARED, D), D_SHARED ** -0.5),
        'g_norm_final': 1.0 + nrm(ks[25], (D,), 0.02),
    }


def reference(x, c, ctx, c_ctx, w_ada, b_ada, g_norm_mix, g_norm_ffn, w_in_even, w_out_even, hgrn_lb_logits,
              g_hgrn_norm, win_sink, w_in_odd, w_out_odd, g_q_norm, g_k_norm, w_router, b_router,
              w_exp_gate, w_exp_up, w_exp_down, w_sh_gate, w_sh_up, w_sh_down, g_norm_final):
    B, L, D = x.shape
    Lc = ctx.shape[1]
    ROWS = L // GRID_W
    rows = jnp.repeat(jnp.arange(ROWS, dtype=jnp.int32), GRID_W)
    cols = jnp.tile(jnp.arange(GRID_W, dtype=jnp.int32), ROWS)
    lb_w = jax.nn.softmax(hgrn_lb_logits.astype(f32), axis=0)
    lower_bounds = jnp.cumsum(lb_w, axis=0)[1:] - lb_w[0]

    for l in range(DEPTH):
        need_ctx = l < DEPTH - 1
        mod = (jax.nn.silu(c) @ w_ada[l] + b_ada[l])[:, None, :]
        mod_c = jax.nn.silu(c_ctx) @ w_ada[l] + b_ada[l]
        sh1, sc1, g1, sh2, sc2, g2 = jnp.split(mod, 6, axis=-1)
        csh1, csc1, cg1, csh2, csc2, cg2 = jnp.split(mod_c, 6, axis=-1)

        h = rms_norm(x, g_norm_mix[l]) * (1.0 + sc1) + sh1
        hc = rms_norm(ctx, g_norm_mix[l]) * (1.0 + csc1) + csh1
        j = l // 2
        if l % 2 == 0:
            y, yc = even_mixer(h, hc, w_in_even[j], w_out_even[j], lower_bounds[l], g_hgrn_norm[j],
                               win_sink[j], rows, cols, need_ctx)
        else:
            y, yc = odd_mixer(h, hc, w_in_odd[j], w_out_odd[j], g_q_norm[j], g_k_norm[j], rows, cols, need_ctx)
        x = x + g1 * y

        h = rms_norm(x, g_norm_ffn[l]) * (1.0 + sc2) + sh2
        moe_params = (w_router[l], b_router[l], w_exp_gate[l], w_exp_up[l], w_exp_down[l],
                      w_sh_gate[l], w_sh_up[l], w_sh_down[l])
        if need_ctx:
            ctx = ctx + cg1 * yc
            hc = rms_norm(ctx, g_norm_ffn[l]) * (1.0 + csc2) + csh2
            out = moe_ffn(jnp.concatenate([h.reshape(B * L, D), hc.reshape(B * Lc, D)], axis=0), *moe_params)
            x = x + g2 * out[:B * L].reshape(B, L, D)
            ctx = ctx + cg2 * out[B * L:].reshape(B, Lc, D)
        else:
            x = x + g2 * moe_ffn(h.reshape(B * L, D), *moe_params).reshape(B, L, D)

    return rms_norm(x, g_norm_final)
```

```cpp
#include <hip/hip_runtime.h>
#include <cstdio>
#include <cstdint>
#include <cstddef>

#ifndef N_LAUNCH_MODE
#define N_LAUNCH_MODE 1
#endif
#define REPEAT_MASK 0u
#define REP(k) for (int rep_ = 0; rep_ < 1 + (int)((REPEAT_MASK >> (k)) & 1u); ++rep_)
#define DBG_NPH 19
#define DBG_BUF_OFF WS_U
#define DBG_BUF_LD 2048
#define DBG_BUF_COL0 0
#define DBG_BUF_NC 2048
#define DBG_NANCHK 2
#define DBG_F32 0
#define DBG_NR 16384
#define DBG_FIN 0

#define LAS __attribute__((address_space(3)))
#define GAS __attribute__((address_space(1)))
typedef unsigned short bf16_t;
typedef short bf16x8 __attribute__((ext_vector_type(8)));
typedef short s16x4 __attribute__((ext_vector_type(4)));
typedef float f32x4 __attribute__((ext_vector_type(4)));
typedef float f32x2 __attribute__((ext_vector_type(2)));
typedef unsigned u32x4 __attribute__((ext_vector_type(4)));
typedef unsigned u32x2 __attribute__((ext_vector_type(2)));

constexpr int D = 2048, NBATCH = 4, SEQ = 4096, CTXL = 256;
constexpr int TL = NBATCH * SEQ, TC = NBATCH * CTXL, TA = TL + TC;
constexpr int EVEN_IN = 6400, ODD_IN = 3072;
constexpr int NE = 64, DEXP = 512;
constexpr int NCHK = 68;
constexpr float EPS = 1e-6f;
constexpr int MODW = 6 * D;

constexpr size_t MiB = 1u << 20;
constexpr size_t WS_CTL = 0, CTL_ZERO_BYTES = 1 * MiB;
constexpr size_t WS_MODS = 1 * MiB;
constexpr size_t WS_TAB = 2 * MiB;
constexpr size_t WS_WR = 3 * MiB;
constexpr size_t WS_WINE = 4 * MiB;
constexpr size_t WS_WOUTE = 29 * MiB;
constexpr size_t WS_WINO = 37 * MiB;
constexpr size_t WS_WOUTO = 49 * MiB;
constexpr size_t WS_WGU = 57 * MiB;
constexpr size_t WS_WDN = 577 * MiB;
constexpr size_t WS_X1 = 837 * MiB;
constexpr size_t WS_H = 973 * MiB;
constexpr size_t WS_CAT = 1041 * MiB;
constexpr size_t WS_LIST = 1109 * MiB;
constexpr size_t WS_WTS = 1113 * MiB + 512 * 1024;
constexpr size_t WS_SLOTI = WS_WTS + (size_t)8 * TA * 4;
constexpr size_t WS_R = 1115 * MiB;
constexpr size_t WS_PE = WS_R, WS_U = WS_R + 213 * MiB, WS_S = WS_R + 349 * MiB, WS_DEC = WS_R + 485 * MiB;
constexpr size_t WS_PO = WS_R, WS_QN = WS_R + 102 * MiB, WS_KALL = WS_R + 166 * MiB, WS_VALL = WS_R + 183 * MiB;
constexpr int MAXTILES = 675;
constexpr size_t WS_HID = WS_R, WS_Y = WS_R + 85 * MiB, WS_H8 = WS_R + 760 * MiB;
constexpr size_t WS_END = WS_R + 794 * MiB;
static_assert((size_t)TA * EVEN_IN * 2 <= 213 * MiB && (size_t)NBATCH * 8 * 2 * NCHK * 128 * 128 * 2 <= 136 * MiB, "even map");
static_assert((size_t)MAXTILES * 256 * 512 <= 85 * MiB && (size_t)MAXTILES * 256 * 2048 * 2 <= 675 * MiB && (size_t)TA * 2048 <= 34 * MiB && (8 * TA + 64 * 255) / 256 + 68 <= MAXTILES, "moe map");
static_assert((size_t)TA * ODD_IN * 2 <= 102 * MiB && (size_t)TL * 2048 * 2 <= 64 * MiB && (size_t)NBATCH * 4352 * 512 * 2 <= 17 * MiB, "odd map");
static_assert(WS_SLOTI + (size_t)8 * TA * 4 <= WS_R && WS_LIST + (size_t)64 * TA * 4 <= WS_WTS, "list / wts / slot info");
constexpr int CW_BAR = 4096;
constexpr int CW_CNT = 16384;
constexpr int CW_Q = 32768;
constexpr int CW_ARR = 32768 + 64;

constexpr int LDS_BYTES = 155648;
constexpr int MISC_OFF = 153600;
constexpr int NWAVES = 8;

typedef __bf16 bf16v2 __attribute__((ext_vector_type(2)));
__device__ __forceinline__ unsigned cvt_pk(float lo, float hi) { f32x2 v = {lo, hi}; bf16v2 b = __builtin_convertvector(v, bf16v2); return __builtin_bit_cast(unsigned, b); }
__device__ __forceinline__ float bflo(unsigned u) { return __uint_as_float(u << 16); }
__device__ __forceinline__ float bfhi(unsigned u) { return __uint_as_float(u & 0xffff0000u); }
__device__ __forceinline__ float bf2f(bf16_t u) { return __uint_as_float(((unsigned)u) << 16); }
__device__ __forceinline__ bf16_t f2bf(float f) { return (bf16_t)(cvt_pk(f, 0.f) & 0xffffu); }
__device__ __forceinline__ unsigned char f2fp8(float f) { return (unsigned char)(__builtin_amdgcn_cvt_pk_fp8_f32(f, 0.f, 0, false) & 0xff); }
__device__ __forceinline__ float wave_sum(float v) {
#pragma unroll
    for (int o = 1; o < 64; o <<= 1) v += __shfl_xor(v, o);
    return v;
}
__device__ __forceinline__ float sigmoidf_(float x) { return __builtin_amdgcn_rcpf(1.0f + __builtin_amdgcn_exp2f(-1.4426950408889634f * x)); }
__device__ __forceinline__ float siluf_(float x) { return x * __builtin_amdgcn_rcpf(1.0f + __builtin_amdgcn_exp2f(-1.4426950408889634f * x)); }
__device__ __forceinline__ int opaque_tid(int wid0) { int t = wid0 * 64 + (int)__builtin_amdgcn_mbcnt_hi(~0u, __builtin_amdgcn_mbcnt_lo(~0u, 0u)); asm volatile("" : "+v"(t)); return t; }
#define LDS_WAIT() asm volatile("s_waitcnt lgkmcnt(0)" ::: "memory")
#define VM_WAIT() asm volatile("s_waitcnt vmcnt(0)" ::: "memory")

#define XB_TMO      128
#define XB_XCNT(j)  (256  + 64 * (j))
#define XB_XSUB(j)  (1280 + 64 * (j))
#define XB_XGEN(j)  (2304 + 64 * (j))
#define XB_TOP      3328
#define XB_TOPGEN   3392
#define XCD_BAR_WORDS 3456
#define XB_SPIN_CAP (1u << 18)
__device__ __forceinline__ unsigned xb_ld(unsigned* p)              { return __hip_atomic_load(p, __ATOMIC_RELAXED, __HIP_MEMORY_SCOPE_AGENT); }
__device__ __forceinline__ unsigned xb_add(unsigned* p, unsigned v) { return __hip_atomic_fetch_add(p, v, __ATOMIC_RELAXED, __HIP_MEMORY_SCOPE_AGENT); }
__device__ __forceinline__ unsigned xb_xcc_id() { return (unsigned)__builtin_amdgcn_s_getreg((3 << 11) | 20) & 0xFu; }
#define XB_SPIN(cond, bar) do { unsigned _sp = 0; while (cond) { __builtin_amdgcn_s_sleep(1); \
    if ((++_sp & 255u) == 0u) { if (xb_ld(&(bar)[XB_TMO])) break; if (_sp > XB_SPIN_CAP) { atomicAdd(&(bar)[XB_TMO], 1u); break; } } } } while (0)
struct XcdBarrier { unsigned* bar; unsigned x; volatile LAS unsigned* st; int wid0; };
__device__ __forceinline__ bool xb_leader(int wid0) { return wid0 == 0 && __builtin_amdgcn_mbcnt_hi(~0u, __builtin_amdgcn_mbcnt_lo(~0u, 0u)) == 0u; }
__device__ __forceinline__ XcdBarrier xcd_barrier_post(unsigned* bar, volatile LAS unsigned* st, int wid0) {
    XcdBarrier b; b.bar = bar; b.x = xb_xcc_id(); b.st = st; b.wid0 = wid0;
    if (xb_leader(wid0)) (void)xb_add(&bar[XB_XCNT(b.x)], 1u);
    return b;
}
__device__ __forceinline__ void xcd_barrier_complete(unsigned* bar, unsigned x, unsigned& nloc, unsigned& nx) {
    const unsigned G = gridDim.x * gridDim.y * gridDim.z;
    unsigned sum, cnt, mine, sp = 0u;
    for (;;) {
        sum = 0u; cnt = 0u; mine = 0u;
#pragma unroll
        for (unsigned j = 0; j < 16; ++j) { const unsigned c = xb_ld(&bar[XB_XCNT(j)]); sum += c; cnt += (c > 0u) ? 1u : 0u; mine = (j == x) ? c : mine; }
        if (sum == G) break;
        __builtin_amdgcn_s_sleep(1);
        if ((++sp & 255u) == 0u) { if (xb_ld(&bar[XB_TMO])) break; if (sp > XB_SPIN_CAP) { atomicAdd(&bar[XB_TMO], 1u); break; } }
    }
    nloc = mine > 0u ? mine : 1u; nx = cnt > 0u ? cnt : 1u;
}
__device__ __forceinline__ void xcd_barrier(const XcdBarrier& b) {
    asm volatile("s_waitcnt vmcnt(0)" ::: "memory");
    __syncthreads();
    if (xb_leader(b.wid0)) {
        unsigned* bar = b.bar;
        __builtin_amdgcn_s_waitcnt(0);
        unsigned nloc = b.st[0], nx = b.st[1];
        if (nloc == 0u) { xcd_barrier_complete(bar, b.x, nloc, nx); b.st[0] = nloc; b.st[1] = nx; }
        const unsigned old = xb_add(&bar[XB_XSUB(b.x)], 1u);
        const unsigned gen = old / nloc;
        if (old + 1u == (gen + 1u) * nloc) {
            __builtin_amdgcn_fence(__ATOMIC_RELEASE, "agent");
            asm volatile("s_waitcnt vmcnt(0)" ::: "memory");
            const unsigned og = xb_add(&bar[XB_TOP], 1u);
            const unsigned tg = og / nx;
            if (og + 1u == (tg + 1u) * nx) xb_add(&bar[XB_TOPGEN], 1u);
            else XB_SPIN(xb_ld(&bar[XB_TOPGEN]) == tg, bar);
            __builtin_amdgcn_fence(__ATOMIC_ACQUIRE, "agent");
            xb_add(&bar[XB_XGEN(b.x)], 1u);
            asm volatile("s_waitcnt vmcnt(0)" ::: "memory");
        } else {
            XB_SPIN(xb_ld(&bar[XB_XGEN(b.x)]) == gen, bar);
            __builtin_amdgcn_fence(__ATOMIC_ACQUIRE, "agent");
            asm volatile("s_waitcnt vmcnt(0)" ::: "memory");
        }
    }
    __syncthreads();
}

namespace pg8 {
constexpr int BM = 256, BK = 64, HALF = 128, HTB = HALF * BK * 2, STAGE_BYTES = 8 * HTB, NXCD = 8, WGM = 8;
__host__ __device__ __forceinline__ int lds_byte(int r, int c) { const int st = (r >> 4) * 2 + (c >> 5), rr = r & 15, cc = c & 31, ob = rr * 64 + cc * 2; return st * 1024 + (ob ^ (((ob >> 9) & 1) << 5)); }
__host__ __device__ __forceinline__ void stage_rc(int b, int& R, int& C) { const int st = b / 1024, sb = b % 1024, swz = sb ^ (((sb >> 9) & 1) << 5); R = (st >> 1) * 16 + swz / 64; C = (st & 1) * 32 + (swz % 64) / 2; }

__host__ __device__ __forceinline__ int perm32(int rho) { const int n = rho >> 4, i = rho & 15; return 8 * (i >> 2) + 4 * n + (i & 3); }
struct Unit { int pm, pn, e, cnt, tb; };

struct DenseSched {
    static constexpr bool DENSE = true;
    int nM, nN, nwg, G, c; unsigned rowbytes; const char* Bt; size_t tstepB;
    __device__ void init(int M, int N, int K, int G_, int c_, const void* Bt_) { nM = M / BM; nN = N / BM; nwg = nM * nN; G = G_; c = c_; rowbytes = (unsigned)K * 2u; Bt = (const char*)Bt_; tstepB = (size_t)256 * K * 2; }
    __device__ __forceinline__ bool next(int i, Unit& u) const {
        const long L = (long)i * G + c; if (L >= nwg) return false;
        int wgid = (int)L; { const int q = nwg / NXCD, r = nwg % NXCD, xcd = wgid % NXCD, off = wgid / NXCD; wgid = (xcd < r ? xcd * (q + 1) : r * (q + 1) + (xcd - r) * q) + off; }
        const int nig = WGM * nN, gid = wgid / nig, fm = gid * WGM, gsz = (nM - fm) < WGM ? (nM - fm) : WGM;
        u.pm = fm + ((wgid % nig) % gsz); u.pn = (wgid % nig) / gsz; u.e = 0; u.cnt = 1 << 30; u.tb = 0; return true;
    }
    __device__ __forceinline__ unsigned arow(const Unit& u, int r) const { return (unsigned)(u.pm * BM + r) * rowbytes; }
    __device__ __forceinline__ const char* bbase(const Unit& u) const { return Bt + (size_t)u.pn * tstepB; }
};
struct MoeSched {
    static constexpr bool DENSE = false; unsigned rowbytes;
    const LAS int* ustart; const LAS int* ecnt; const LAS int* tstart; int total, G, c, NT, mode; const int* list; const char* Bt; size_t estepB, tstepB;
    __device__ __forceinline__ bool next(int i, Unit& u) const {
        const long Lx = (long)i * G + c; if (Lx >= total) return false; const int L = (int)Lx;
        int lo = 0, hi = 65; while (hi - lo > 1) { const int mid = (lo + hi) >> 1; if (ustart[mid] <= L) lo = mid; else hi = mid; }
        const int loc = L - ustart[lo]; u.e = lo; u.pm = loc / NT; u.pn = loc % NT; u.cnt = ecnt[lo]; u.tb = tstart[lo] + u.pm; return true;
    }
    __device__ __forceinline__ unsigned arow(const Unit& u, int r) const {
        if (mode == 1) return (unsigned)(u.tb * BM + r) * 512u;
        int p = u.pm * BM + r; if (p >= u.cnt) p = 0;
        const int tok = (u.e == 64) ? p : list[(size_t)u.e * TA + p];
        return (unsigned)tok * 2048u;
    }
    __device__ __forceinline__ const char* bbase(const Unit& u) const { return Bt + (size_t)u.e * estepB + (size_t)u.pn * tstepB; }
};

typedef int v8i_t __attribute__((ext_vector_type(8)));
typedef int v4i_t __attribute__((ext_vector_type(4)));
template <class Epi, class Sched, bool ALIGN_EPI, int WSCALE = 0>
__device__ __forceinline__ void gemm_phase(LAS unsigned char* lds, const char* Abase, const int K, const Sched& S, const Epi& E, const int wid0) {
    const int tid = opaque_tid(wid0), wid = __builtin_amdgcn_readfirstlane(tid >> 6), lane = tid & 63, wr = wid >> 2, wc = wid & 3, fr = lane & 15, fq = lane >> 4;
    const int nt = K / BK;
    unsigned voffB[2];
#pragma unroll
    for (int i = 0; i < 2; ++i) { int R, C; stage_rc(tid * 16 + i * 8192, R, C); const int Rb = Epi::PERM ? ((R & ~31) + perm32(R & 31)) : R; voffB[i] = (unsigned)(Rb * K + C) * 2u; }
#define PG8_AOFF(dst0, dst1, U) do { _Pragma("unroll") for (int _i = 0; _i < 2; ++_i) { int _R, _C; stage_rc(tid * 16 + _i * 8192, _R, _C); \
        dst0[_i] = S.arow(U, _R) + (unsigned)_C * 2u; if constexpr (!Sched::DENSE) dst1[_i] = S.arow(U, _R + HALF) + (unsigned)_C * 2u; } } while (0)
    const size_t hstepA = Sched::DENSE ? (size_t)HALF * S.rowbytes : (size_t)0;
#define PG8_CV1 (Sched::DENSE ? cv0 : cv1)
    const size_t hstep = (size_t)HALF * K * 2;
    const unsigned ldsw = (unsigned)wid * 1024u;
    const int aoff = lds_byte(wr * 64 + fr, fq * 8), boff = lds_byte(wc * 32 + fr, fq * 8);
#define PG8_SA(b, h) (((b) * 2 + (h)) * HTB)
#define PG8_SB(b, h) ((4 + (b) * 2 + (h)) * HTB)
#define PG8_STAGE(bufoff, gbase, voff) do { _Pragma("unroll") for (int _i = 0; _i < 2; ++_i) \
        __builtin_amdgcn_global_load_lds((const unsigned*)((const char*)(gbase) + (voff)[_i]), (LAS unsigned*)(lds + (bufoff) + ldsw + _i * 8192), 16, 0, 0); } while (0)
#define PG8_LDA(dst, b, h) do { _Pragma("unroll") for (int m = 0; m < 4; ++m) { const v4i_t lo_ = *(const LAS v4i_t*)(lds + PG8_SA(b, h) + aoff + m * 2048), hi_ = *(const LAS v4i_t*)(lds + PG8_SA(b, h) + aoff + m * 2048 + 1024); \
        dst[m] = __builtin_shufflevector(lo_, hi_, 0, 1, 2, 3, 4, 5, 6, 7); } } while (0)
#define PG8_LDB(dst, b, h) do { _Pragma("unroll") for (int n = 0; n < 2; ++n) { const v4i_t lo_ = *(const LAS v4i_t*)(lds + PG8_SB(b, h) + boff + n * 2048), hi_ = *(const LAS v4i_t*)(lds + PG8_SB(b, h) + boff + n * 2048 + 1024); \
        dst[n] = __builtin_shufflevector(lo_, hi_, 0, 1, 2, 3, 4, 5, 6, 7); } } while (0)
#define PG8_LO(x) __builtin_bit_cast(bf16x8, __builtin_shufflevector(x, x, 0, 1, 2, 3))
#define PG8_HI(x) __builtin_bit_cast(bf16x8, __builtin_shufflevector(x, x, 4, 5, 6, 7))
#define PG8_MMA(ai, bj, At, Bt) do { __builtin_amdgcn_s_setprio(1); _Pragma("unroll") for (int m = 0; m < 4; ++m) _Pragma("unroll") for (int n = 0; n < 2; ++n) { \
        if constexpr (WSCALE != 0) asm volatile("v_mfma_scale_f32_16x16x128_f8f6f4 %0, %1, %2, %0, %3, %4 op_sel_hi:[0,0,0]" : "+v"(acc[ai][bj][m][n]) : "v"(Bt[n]), "v"(At[m]), "v"(scw), "v"(sca)); \
        else { acc[ai][bj][m][n] = __builtin_amdgcn_mfma_f32_16x16x32_bf16(PG8_LO(Bt[n]), PG8_LO(At[m]), acc[ai][bj][m][n], 0, 0, 0); \
               acc[ai][bj][m][n] = __builtin_amdgcn_mfma_f32_16x16x32_bf16(PG8_HI(Bt[n]), PG8_HI(At[m]), acc[ai][bj][m][n], 0, 0, 0); } } \
        __builtin_amdgcn_s_setprio(0); } while (0)
#define PG8_WAIT_V(n) asm volatile("s_waitcnt vmcnt(" #n ")" ::: "memory")
#define PG8_WAIT_L(n) asm volatile("s_waitcnt lgkmcnt(" #n ")" ::: "memory")
#define PG8_BAR __builtin_amdgcn_s_barrier()
#define PG8_SCHED __builtin_amdgcn_sched_barrier(0)
    Unit cur, nxt; int ui = 0;
    if (!S.next(0, cur)) return;
    f32x4 acc[2][2][4][2];
#pragma unroll
    for (int a = 0; a < 2; ++a)
#pragma unroll
        for (int b = 0; b < 2; ++b)
#pragma unroll
            for (int m = 0; m < 4; ++m)
#pragma unroll
                for (int n = 0; n < 2; ++n) acc[a][b][m][n] = (f32x4){0.f, 0.f, 0.f, 0.f};
    v8i_t At[4], B0[2], B1[2];
    int scw = WSCALE, sca = 127; asm volatile("" : "+v"(scw), "+v"(sca));
    unsigned cv0[2], cv1[2];
    PG8_AOFF(cv0, cv1, cur);
    const char* cB = S.bbase(cur);
    PG8_STAGE(PG8_SB(0, 0), cB, voffB); PG8_STAGE(PG8_SA(0, 0), Abase, cv0); PG8_STAGE(PG8_SB(0, 1), cB + hstep, voffB); PG8_STAGE(PG8_SA(0, 1), Abase + hstepA, PG8_CV1);
    if (wr == 1) PG8_BAR;
    PG8_WAIT_V(4); PG8_BAR;
    PG8_STAGE(PG8_SB(1, 0), cB + 128, voffB); PG8_STAGE(PG8_SA(1, 0), Abase + 128, cv0); PG8_STAGE(PG8_SB(1, 1), cB + hstep + 128, voffB);
    PG8_WAIT_V(6); PG8_BAR;
#define PG8_TRIP(LASTF) do { \
        const char* a1 = Abase + (size_t)(t + 1) * 128; \
        const char* a2 = Abase + ((LASTF) ? (size_t)0 : (size_t)(t + 2) * 128); const char* b2 = (LASTF) ? nB : cB + (size_t)(t + 2) * 128; \
        const char* a3 = a2 + 128; const char* b3 = b2 + 128; \
        PG8_LDB(B0, 0, 0); PG8_SCHED; PG8_LDA(At, 0, 0); PG8_STAGE(PG8_SA(1, 1), a1 + hstepA, PG8_CV1); \
        PG8_WAIT_L(8); PG8_BAR; PG8_WAIT_L(0); PG8_MMA(0, 0, At, B0); PG8_BAR; PG8_SCHED; \
        if (LASTF) { if (has_next) PG8_AOFF(cv0, cv1, nxt); } \
        PG8_LDB(B1, 0, 1); PG8_STAGE(PG8_SB(0, 0), b2, voffB); \
        PG8_BAR; PG8_WAIT_L(0); PG8_MMA(0, 1, At, B1); PG8_BAR; \
        PG8_LDA(At, 0, 1); PG8_STAGE(PG8_SA(0, 0), a2, cv0); \
        PG8_BAR; PG8_WAIT_L(0); PG8_MMA(1, 0, At, B0); PG8_BAR; PG8_SCHED; \
        PG8_STAGE(PG8_SB(0, 1), b2 + hstep, voffB); \
        PG8_WAIT_V(6); PG8_BAR; PG8_MMA(1, 1, At, B1); PG8_BAR; \
        PG8_LDB(B0, 1, 0); PG8_SCHED; PG8_LDA(At, 1, 0); PG8_STAGE(PG8_SA(0, 1), a2 + hstepA, PG8_CV1); \
        PG8_WAIT_L(8); PG8_BAR; PG8_WAIT_L(0); PG8_MMA(0, 0, At, B0); PG8_BAR; PG8_SCHED; \
        PG8_LDB(B1, 1, 1); PG8_STAGE(PG8_SB(1, 0), b3, voffB); \
        PG8_BAR; PG8_WAIT_L(0); PG8_MMA(0, 1, At, B1); PG8_BAR; \
        PG8_LDA(At, 1, 1); PG8_STAGE(PG8_SA(1, 0), a3, cv0); \
        PG8_BAR; PG8_WAIT_L(0); PG8_MMA(1, 0, At, B0); PG8_BAR; PG8_SCHED; \
        PG8_STAGE(PG8_SB(1, 1), b3 + hstep, voffB); \
        PG8_WAIT_V(6); PG8_BAR; PG8_MMA(1, 1, At, B1); PG8_BAR; \
    } while (0)
    for (;;) {
        const bool has_next = S.next(ui + 1, nxt);
        const char* nB = has_next ? S.bbase(nxt) : cB;
        int t = 0;
#pragma nounroll
        for (; t < nt - 2; t += 2) { if constexpr (Epi::ASPLIT >= 0) { sca = t >= Epi::ASPLIT ? 127 - 4 : 127; asm volatile("" : "+v"(sca)); } PG8_TRIP(false); }
        if constexpr (Epi::ASPLIT >= 0) { sca = t >= Epi::ASPLIT ? 127 - 4 : 127; asm volatile("" : "+v"(sca)); }
        PG8_TRIP(true);
        if constexpr (ALIGN_EPI) { if (wr == 0) PG8_BAR; }
        if constexpr (WSCALE != 0) asm volatile("s_nop 15\n\ts_nop 15\n\ts_nop 15" ::: "memory");
        E(acc, cur, wr, wc, fr, fq);
        if (!has_next) break;
#pragma unroll
        for (int a = 0; a < 2; ++a)
#pragma unroll
            for (int b = 0; b < 2; ++b)
#pragma unroll
                for (int m = 0; m < 4; ++m)
#pragma unroll
                    for (int n = 0; n < 2; ++n) acc[a][b][m][n] = (f32x4){0.f, 0.f, 0.f, 0.f};
        cur = nxt; cB = nB; ++ui;
        if constexpr (ALIGN_EPI) { if (wr == 1) PG8_BAR; }
    }
    PG8_WAIT_V(0);
    if constexpr (!ALIGN_EPI) { if (wr == 0) PG8_BAR; }
    PG8_BAR;
#undef PG8_TRIP
#undef PG8_AOFF
#undef PG8_CV1
#undef PG8_SA
#undef PG8_SB
#undef PG8_STAGE
#undef PG8_LDA
#undef PG8_LDB
#undef PG8_MMA
#undef PG8_LO
#undef PG8_HI
#undef PG8_WAIT_V
#undef PG8_WAIT_L
#undef PG8_BAR
#undef PG8_SCHED
}

struct EpiProj {
    static constexpr bool PERM = false; static constexpr int ASPLIT = -1;
    bf16_t* O; int ld; int rope_lo, rope_hi, rope_half;
    const float* tab;
    __device__ __forceinline__ void operator()(const f32x4 (&acc)[2][2][4][2], const Unit& u, int wr, int wc, int fr, int fq) const {
        const int row0 = u.pm * BM + wr * 64 + fr, col0 = u.pn * BM + wc * 32 + 4 * fq;
        const bool lat = (u.pm * BM) < TL;
        const bool rfull = lat && u.pn >= rope_lo && u.pn < rope_hi, rhalf = lat && u.pn == rope_half;
#pragma unroll
        for (int ai = 0; ai < 2; ++ai)
#pragma unroll
            for (int m = 0; m < 4; ++m) {
                const int r = row0 + ai * HALF + m * 16;
                f32x4 cs = (f32x4){1.f, 1.f, 1.f, 1.f}, sn = (f32x4){0.f, 0.f, 0.f, 0.f};
                if (rfull || rhalf) { const int t = r & (SEQ - 1); const int pos = (wc & 1) ? (t & 63) : (t >> 6);
                    cs = *(const f32x4*)(tab + pos * 16 + 4 * fq); sn = *(const f32x4*)(tab + 1024 + pos * 16 + 4 * fq); }
                bf16_t* rowp = O + (size_t)r * ld + col0;
#pragma unroll
                for (int bj = 0; bj < 2; ++bj) {
                    f32x4 x1 = acc[ai][bj][m][0], x2 = acc[ai][bj][m][1];
                    if (rfull || (rhalf && bj == 0)) { const f32x4 y1 = x1 * cs - x2 * sn, y2 = x2 * cs + x1 * sn; x1 = y1; x2 = y2; }
                    u32x2 w0, w1; w0.x = cvt_pk(x1[0], x1[1]); w0.y = cvt_pk(x1[2], x1[3]); w1.x = cvt_pk(x2[0], x2[1]); w1.y = cvt_pk(x2[2], x2[3]);
                    *(u32x2*)(rowp + bj * HALF) = w0; *(u32x2*)(rowp + bj * HALF + 16) = w1;
                }
            }
    }
};
template <bool BASE_BF16> struct EpiOutRes {
    static constexpr bool PERM = false; static constexpr int ASPLIT = BASE_BF16 ? 0 : 8;
    const float* base_lat; const float* base_ctx; bf16_t* out; const float* gate;
    __device__ __forceinline__ void operator()(const f32x4 (&acc)[2][2][4][2], const Unit& u, int wr, int wc, int fr, int fq) const {
        const int row0 = u.pm * BM + wr * 64 + fr, col0 = u.pn * BM + wc * 32 + 4 * fq;
        const bool lat = (u.pm * BM) < TL; const int rt = lat ? (u.pm >> 4) : 4;
        const float* bs = lat ? base_lat : base_ctx - (size_t)TL * D;
        f32x4 gv[2][2];
#pragma unroll
        for (int bj = 0; bj < 2; ++bj)
#pragma unroll
            for (int n = 0; n < 2; ++n) gv[bj][n] = *(const f32x4*)(gate + (size_t)rt * MODW + col0 + bj * HALF + n * 16);
#pragma unroll
        for (int ai = 0; ai < 2; ++ai)
#pragma unroll
            for (int m = 0; m < 4; ++m) { const size_t off = (size_t)(row0 + ai * HALF + m * 16) * D + col0;
#pragma unroll
                for (int bj = 0; bj < 2; ++bj)
#pragma unroll
                    for (int n = 0; n < 2; ++n) { f32x4 b;
                        if constexpr (BASE_BF16) { const u32x2 w = *(const u32x2*)(out + off + bj * HALF + n * 16); b = (f32x4){bflo(w.x), bfhi(w.x), bflo(w.y), bfhi(w.y)}; }
                        else b = *(const f32x4*)(bs + off + bj * HALF + n * 16);
                        const f32x4 y = b + gv[bj][n] * acc[ai][bj][m][n]; u32x2 o; o.x = cvt_pk(y[0], y[1]); o.y = cvt_pk(y[2], y[3]); *(u32x2*)(out + off + bj * HALF + n * 16) = o; }
                asm volatile("" ::: "memory"); }
    }
};
struct EpiGateUp {
    static constexpr bool PERM = true; static constexpr int ASPLIT = -1;
    unsigned char* hid;
    __device__ __forceinline__ void operator()(const f32x4 (&acc)[2][2][4][2], const Unit& u, int wr, int wc, int fr, int fq) const {
        const int colh = u.pn * 128 + wc * 32 + 8 * fq;
#pragma unroll
        for (int ai = 0; ai < 2; ++ai)
#pragma unroll
            for (int m = 0; m < 4; ++m) {
                unsigned char* rowp = hid + (size_t)(u.tb * BM + ai * HALF + wr * 64 + m * 16 + fr) * DEXP + colh;
                u32x2 o;
#pragma unroll
                for (int n = 0; n < 2; ++n) { const f32x4 g = acc[ai][0][m][n], up = acc[ai][1][m][n]; f32x4 h;
#pragma unroll
                    for (int j = 0; j < 4; ++j) h[j] = g[j] * __builtin_amdgcn_rcpf(1.0f + __expf(-g[j])) * up[j];
                    int w = 0; w = __builtin_amdgcn_cvt_pk_fp8_f32(h[0], h[1], w, false); w = __builtin_amdgcn_cvt_pk_fp8_f32(h[2], h[3], w, true);
                    if (n == 0) o.x = (unsigned)w; else o.y = (unsigned)w; }
                *(u32x2*)rowp = o;
            }
    }
};
struct EpiDown {
    static constexpr bool PERM = true; static constexpr int ASPLIT = -1;
    unsigned char* y;
    __device__ __forceinline__ void operator()(const f32x4 (&acc)[2][2][4][2], const Unit& u, int wr, int wc, int fr, int fq) const {
        const int col0 = u.pn * BM + wc * 32 + 8 * fq;
#pragma unroll
        for (int ai = 0; ai < 2; ++ai)
#pragma unroll
            for (int m = 0; m < 4; ++m) {
                unsigned char* rowp = y + (size_t)(u.tb * BM + ai * HALF + wr * 64 + m * 16 + fr) * D + col0;
#pragma unroll
                for (int bj = 0; bj < 2; ++bj) { const f32x4 v0 = acc[ai][bj][m][0], v1 = acc[ai][bj][m][1]; int w0 = 0, w1 = 0;
                    w0 = __builtin_amdgcn_cvt_pk_fp8_f32(v0[0], v0[1], w0, false); w0 = __builtin_amdgcn_cvt_pk_fp8_f32(v0[2], v0[3], w0, true);
                    w1 = __builtin_amdgcn_cvt_pk_fp8_f32(v1[0], v1[1], w1, false); w1 = __builtin_amdgcn_cvt_pk_fp8_f32(v1[2], v1[3], w1, true);
                    u32x2 o; o.x = (unsigned)w0; o.y = (unsigned)w1; *(u32x2*)(rowp + bj * HALF) = o; }
            }
    }
};
}

namespace ga {
constexpr int DH = 128, QBLK = 32, KVBLK = 64, LDQ = 2048, LDK = 512, LDO = 2048;
constexpr float SCALE = 0.088388347648318440f;
constexpr float THR = 5.f;
constexpr size_t SHM_V = KVBLK * DH * 2, SHM_K = KVBLK * DH * 2, SHM_ATTN = 2 * SHM_V + 2 * SHM_K + NWAVES * 64 * 4;
typedef float f32x16 __attribute__((ext_vector_type(16)));
#define KSWZ(row, colB) ((row) * 256 + ((colB) ^ (((row) & 7) << 4)))
#define SBAR() __builtin_amdgcn_sched_barrier(0)
__device__ __forceinline__ int crow(int r, int hi) { return (r & 3) + 8 * (r >> 2) + 4 * hi; }
__device__ __forceinline__ void partialSM(f32x16& p0, f32x16& p1, float& m_reg, float& mn, float& alpha) {
  constexpr float C = SCALE * 1.4426950408889634f;
  float pmax = p0[0]; for (int r = 1; r < 16; ++r) pmax = fmaxf(pmax, p0[r]); for (int r = 0; r < 16; ++r) pmax = fmaxf(pmax, p1[r]);
  { auto rr = __builtin_amdgcn_permlane32_swap(__float_as_uint(pmax), __float_as_uint(pmax), false, false);
    pmax = fmaxf(__uint_as_float(rr[0]), __uint_as_float(rr[1])); }
  if (__builtin_expect(__all(pmax - m_reg <= THR / SCALE), 1)) { mn = m_reg; alpha = 1.f; }
  else { mn = fmaxf(m_reg, pmax); alpha = __builtin_amdgcn_exp2f((m_reg - mn) * C); m_reg = mn; }
  float mnC = -mn * C;
  for (int r = 0; r < 16; ++r) p0[r] = fmaf(p0[r], C, mnC); for (int r = 0; r < 16; ++r) p1[r] = fmaf(p1[r], C, mnC);
  for (int r = 0; r < 16; ++r) p0[r] = __builtin_amdgcn_exp2f(p0[r]);
}
typedef int v8i_p __attribute__((ext_vector_type(8)));
__device__ __forceinline__ void finishSM(f32x16& p0, f32x16& p1, float alpha, float& l_reg, v8i_p& pf) {
  for (int r = 0; r < 16; ++r) p1[r] = __builtin_amdgcn_exp2f(p1[r]);
  float ps = 0; for (int r = 0; r < 16; ++r) ps += p0[r]; for (int r = 0; r < 16; ++r) ps += p1[r];
  { auto rr = __builtin_amdgcn_permlane32_swap(__float_as_uint(ps), __float_as_uint(ps), false, false);
    ps = __uint_as_float(rr[0]) + __uint_as_float(rr[1]); }
  l_reg = l_reg * alpha + ps;
#pragma unroll
  for (int i = 0; i < 4; ++i) { int w = 0; w = __builtin_amdgcn_cvt_pk_fp8_f32(p0[4 * i], p0[4 * i + 1], w, false); w = __builtin_amdgcn_cvt_pk_fp8_f32(p0[4 * i + 2], p0[4 * i + 3], w, true); pf[i] = w;
    int u = 0; u = __builtin_amdgcn_cvt_pk_fp8_f32(p1[4 * i], p1[4 * i + 1], u, false); u = __builtin_amdgcn_cvt_pk_fp8_f32(p1[4 * i + 2], p1[4 * i + 3], u, true); pf[4 + i] = u; }
}
typedef int v8i_a __attribute__((ext_vector_type(8)));
typedef int v4i_a __attribute__((ext_vector_type(4)));
__device__ __forceinline__ int k8_off(int row, int chunk) { return row * 128 + ((chunk ^ ((row >> 1) & 7)) << 4); }
__device__ __forceinline__ void qkt(f32x16& p0, f32x16& p1, const char* Ks, const v8i_a* q8, int r32, int hi) {
  p0 = f32x16{}; p1 = f32x16{};
#pragma unroll
  for (int m = 0; m < 2; ++m) {
    const v4i_a a0l = *reinterpret_cast<const v4i_a*>(Ks + k8_off(r32, hi * 4 + 2 * m)), a0h = *reinterpret_cast<const v4i_a*>(Ks + k8_off(r32, hi * 4 + 2 * m + 1));
    const v4i_a a1l = *reinterpret_cast<const v4i_a*>(Ks + k8_off(32 + r32, hi * 4 + 2 * m)), a1h = *reinterpret_cast<const v4i_a*>(Ks + k8_off(32 + r32, hi * 4 + 2 * m + 1));
    const v8i_a a0 = __builtin_shufflevector(a0l, a0h, 0, 1, 2, 3, 4, 5, 6, 7), a1 = __builtin_shufflevector(a1l, a1h, 0, 1, 2, 3, 4, 5, 6, 7);
    p0 = __builtin_amdgcn_mfma_scale_f32_32x32x64_f8f6f4(a0, q8[m], p0, 0, 0, 0, 127, 0, 127);
    p1 = __builtin_amdgcn_mfma_scale_f32_32x32x64_f8f6f4(a1, q8[m], p1, 0, 0, 0, 127, 0, 127); }
}
__device__ __forceinline__ int vt_off(int d, int byte) { return d * 64 + ((((byte >> 4) ^ ((d >> 2) & 3))) << 4) + (byte & 15); }
__device__ __forceinline__ int vt_pos(int k) { const int k32 = k & 31; return ((k32 >> 2) & 1) * 32 + (k >> 5) * 16 + (k32 & 3) + 4 * (k32 >> 3); }
template <int D0> __device__ __forceinline__ void pv_one(f32x16& od, const char* VT, v8i_p pf, int r32, int hi) {
  const int d = 32 * D0 + r32;
  const v4i_a bl = *reinterpret_cast<const v4i_a*>(VT + vt_off(d, 32 * hi)), bh = *reinterpret_cast<const v4i_a*>(VT + vt_off(d, 32 * hi + 16));
  od = __builtin_amdgcn_mfma_scale_f32_32x32x64_f8f6f4(pf, __builtin_shufflevector(bl, bh, 0, 1, 2, 3, 4, 5, 6, 7), od, 0, 0, 0, 127, 0, 127);
}
__device__ __forceinline__ void pv_d0(f32x16* o, const char* VT, v8i_p pf, int r32, int hi) {
  pv_one<0>(o[0], VT, pf, r32, hi); pv_one<1>(o[1], VT, pf, r32, hi); pv_one<2>(o[2], VT, pf, r32, hi); pv_one<3>(o[3], VT, pf, r32, hi);
}
__device__ __forceinline__ u32x2 k8pack(bf16x8 v) { const u32x4 w = __builtin_bit_cast(u32x4, v); int a = 0, b = 0;
  a = __builtin_amdgcn_cvt_pk_fp8_f32(bflo(w.x), bfhi(w.x), a, false); a = __builtin_amdgcn_cvt_pk_fp8_f32(bflo(w.y), bfhi(w.y), a, true); b = __builtin_amdgcn_cvt_pk_fp8_f32(bflo(w.z), bfhi(w.z), b, false); b = __builtin_amdgcn_cvt_pk_fp8_f32(bflo(w.w), bfhi(w.w), b, true);
  u32x2 o; o.x = (unsigned)a; o.y = (unsigned)b; return o; }
__device__ __forceinline__ void attn_dense_body(const bf16_t* __restrict__ Qb, const float* __restrict__ gq, const float* __restrict__ tab, int t0, const unsigned char* __restrict__ Kh, const unsigned char* __restrict__ Vh,
                                                unsigned char* __restrict__ Ob, int seq, char* lds, const int wid0) {
  const int tid = opaque_tid(wid0), wid = tid >> 6, lane = tid & 63, r32 = lane & 31, hi = lane >> 5;
  char* V_lds = lds; char* K_lds = lds + 2 * SHM_V;
  float* ws = (float*)(lds + 2 * SHM_V + 2 * SHM_K) + wid * 64; float* li_l = ws; float* al_l = ws + 32;
  float m_reg = -1e30f, l_reg = 0; f32x16 o[4] = {}; v8i_a qr[2];
  { const bf16_t* Qw = Qb + (long)(wid * QBLK + r32) * ODD_IN + hi * 8;
    u32x4 raw[8]; float ss = 0.f;
#pragma unroll
    for (int d0 = 0; d0 < 8; ++d0) { raw[d0] = *reinterpret_cast<const u32x4*>(Qw + d0 * 16);
      const float a0 = bflo(raw[d0].x), a1 = bfhi(raw[d0].x), a2 = bflo(raw[d0].y), a3 = bfhi(raw[d0].y), a4 = bflo(raw[d0].z), a5 = bfhi(raw[d0].z), a6 = bflo(raw[d0].w), a7 = bfhi(raw[d0].w);
      ss += (a0 * a0 + a1 * a1) + (a2 * a2 + a3 * a3) + (a4 * a4 + a5 * a5) + (a6 * a6 + a7 * a7); }
    ss += __shfl_xor(ss, 32);
    const float rstd = rsqrtf(ss * (1.0f / 128.0f) + EPS);
    const int t = t0 + wid * QBLK + r32, posr = t >> 6, posc = t & 63;
#pragma unroll
    for (int d0 = 0; d0 < 8; ++d0) { const int hf = d0 >> 2, pos = hf ? posc : posr, jb = 8 * (d0 & 3) + 4 * hi;
      const f32x4 cs = *(const f32x4*)(tab + pos * 32 + jb), sn = *(const f32x4*)(tab + 2048 + pos * 32 + jb), g1 = *(const f32x4*)(gq + 64 * hf + jb) * rstd, g2 = *(const f32x4*)(gq + 64 * hf + 32 + jb) * rstd;
      const unsigned rw[4] = {raw[d0].x, raw[d0].y, raw[d0].z, raw[d0].w}; float oo[8];
#pragma unroll
      for (int pi = 0; pi < 4; ++pi) { const float y1 = bflo(rw[pi]) * g1[pi], y2 = bfhi(rw[pi]) * g2[pi]; oo[2 * pi] = y1 * cs[pi] - y2 * sn[pi]; oo[2 * pi + 1] = y2 * cs[pi] + y1 * sn[pi]; }
      int wa = 0, wb = 0; wa = __builtin_amdgcn_cvt_pk_fp8_f32(oo[0], oo[1], wa, false); wa = __builtin_amdgcn_cvt_pk_fp8_f32(oo[2], oo[3], wa, true); wb = __builtin_amdgcn_cvt_pk_fp8_f32(oo[4], oo[5], wb, false); wb = __builtin_amdgcn_cvt_pk_fp8_f32(oo[6], oo[7], wb, true);
      qr[d0 >> 2][2 * (d0 & 3)] = wa; qr[d0 >> 2][2 * (d0 & 3) + 1] = wb; } }
  struct { bf16x8 vs0, ks0; } sr_[2];
#define SLOAD(i, k0) do { sr_[i].vs0 = *reinterpret_cast<const bf16x8*>(Vh + (size_t)((k0) >> 6) * 8192 + tid * 16); sr_[i].ks0 = *reinterpret_cast<const bf16x8*>(Kh + (size_t)((k0) >> 6) * 8192 + tid * 16); } while (0)
#define SWRITE(b, i) do { *(bf16x8*)(V_lds + (b) * SHM_V + tid * 16) = sr_[i].vs0; *(bf16x8*)(K_lds + (b) * SHM_K + tid * 16) = sr_[i].ks0; } while (0)
#define SWAIT() asm volatile("s_waitcnt vmcnt(2)" ::: "memory")
#define RESC(a) do { if (__any((a) < 1.f)) { if (hi == 0) al_l[r32] = (a); asm volatile("s_waitcnt lgkmcnt(0)" ::: "memory"); \
    for (int d = 0; d < 4; ++d) for (int r = 0; r < 16; ++r) o[d][r] *= al_l[crow(r, hi)]; } } while (0)
  f32x16 pA0, pA1, pB0, pB1; float mnA, mnB, alA, alB; v8i_p pf; const int NT = seq / KVBLK;
  constexpr int SE = 0, SO = 1;
  SLOAD(SE, 0); asm volatile("s_waitcnt vmcnt(0)" ::: "memory"); SWRITE(0, SE); __syncthreads();
  qkt(pA0, pA1, K_lds, qr, r32, hi); partialSM(pA0, pA1, m_reg, mnA, alA);
  SLOAD(SO, KVBLK); if (2 < NT) SLOAD(SE, 2 * KVBLK);
  SWAIT(); SWRITE(1, SO); __syncthreads();
  for (int j = 1; j + 1 < NT; j += 2) {
    SBAR(); qkt(pB0, pB1, K_lds + SHM_K, qr, r32, hi);
    finishSM(pA0, pA1, alA, l_reg, pf); SBAR();
    SLOAD(SO, (j + 2) * KVBLK); SBAR();
    pv_d0(o, V_lds, pf, r32, hi); partialSM(pB0, pB1, m_reg, mnB, alB);
    __syncthreads(); SWAIT(); SWRITE(0, SE);
    RESC(alB); __syncthreads();
    SBAR(); qkt(pA0, pA1, K_lds, qr, r32, hi);
    finishSM(pB0, pB1, alB, l_reg, pf); SBAR();
    if (j + 3 < NT) SLOAD(SE, (j + 3) * KVBLK); SBAR();
    pv_d0(o, V_lds + SHM_V, pf, r32, hi); partialSM(pA0, pA1, m_reg, mnA, alA);
    __syncthreads(); SWAIT(); SWRITE(1, SO);
    RESC(alA); __syncthreads();
  }
  SBAR(); qkt(pB0, pB1, K_lds + SHM_K, qr, r32, hi);
  finishSM(pA0, pA1, alA, l_reg, pf); SBAR();
  pv_d0(o, V_lds, pf, r32, hi); partialSM(pB0, pB1, m_reg, mnB, alB);
  __syncthreads(); RESC(alB);
  finishSM(pB0, pB1, alB, l_reg, pf); SBAR();
  pv_d0(o, V_lds + SHM_V, pf, r32, hi);
  if (hi == 0) li_l[r32] = l_reg; asm volatile("s_waitcnt lgkmcnt(0)" ::: "memory");
  float rli[16];
#pragma unroll
  for (int r = 0; r < 16; ++r) rli[r] = __builtin_amdgcn_rcpf(li_l[crow(r, hi)]);
  unsigned char* Ow = Ob + (long)(wid * QBLK) * LDO;
#pragma unroll
  for (int r = 0; r < 16; ++r) { int orow = crow(r, hi);
    for (int d0 = 0; d0 < 4; ++d0) Ow[(long)orow * LDO + d0 * 32 + r32] = f2fp8(o[d0][r] * rli[r] * 16.0f); }
  __syncthreads();
#undef SLOAD
#undef SWRITE
#undef SWAIT
#undef RESC
}
}

__device__ __forceinline__ void win_attn_item(char* lds, const bf16_t* __restrict__ P, bf16_t* __restrict__ cat, const float* __restrict__ sink, int b, int h, int qb, bool isctx, const int wid0) {
    const int tid = opaque_tid(wid0), wid = tid >> 6, lane = tid & 63, lq = lane & 15, g = lane >> 4;
    const int kvh = h >> 3;
    char* Ks = lds; char* Vs = lds + 128 * 144;
    const size_t qrow0 = isctx ? (size_t)(TL + b * CTXL + qb * 128) : (size_t)(b * SEQ + qb * 128);
    const bf16_t* qp = P + (qrow0 + wid * 16 + lq) * EVEN_IN + 5120 + h * 64 + 8 * g;
    const bf16x8 qf0 = *(const bf16x8*)qp, qf1 = *(const bf16x8*)(qp + 32);
    float m = sink[h], l = 1.0f;
    f32x4 o[4];
#pragma unroll
    for (int dt = 0; dt < 4; ++dt) o[dt] = (f32x4){0.f, 0.f, 0.f, 0.f};
    const int ntile = isctx ? 2 : 5;
    const int iq = wid * 16 + lq;
    for (int ti = 0; ti < ntile; ++ti) {
        int kind; size_t krow0;
        if (isctx) { kind = 3; krow0 = (size_t)(TL + b * CTXL + ti * 128); }
        else if (ti < 3) { const int kbi = qb - 1 + ti; if (kbi < 0 || kbi >= SEQ / 128) continue; kind = ti; krow0 = (size_t)(b * SEQ + kbi * 128); }
        else { kind = 3; krow0 = (size_t)(TL + b * CTXL + (ti - 3) * 128); }
        __syncthreads();
        { const int r = tid >> 2, c = (tid & 3) * 16; const bf16_t* kp = P + (krow0 + r) * EVEN_IN + 6144 + kvh * 64 + c; const bf16_t* vp = kp + 128;
          const bf16x8 k0 = *(const bf16x8*)kp, k1 = *(const bf16x8*)(kp + 8), v0 = *(const bf16x8*)vp, v1 = *(const bf16x8*)(vp + 8);
          *(bf16x8*)(Ks + r * 144 + c * 2) = k0; *(bf16x8*)(Ks + r * 144 + c * 2 + 16) = k1;
          *(bf16x8*)(Vs + r * 144 + c * 2) = v0; *(bf16x8*)(Vs + r * 144 + c * 2 + 16) = v1; }
        __syncthreads();
        f32x4 st[8];
#pragma unroll
        for (int kt = 0; kt < 8; ++kt) {
            const bf16x8 kf0 = *(const bf16x8*)(Ks + (16 * kt + lq) * 144 + 16 * g), kf1 = *(const bf16x8*)(Ks + (16 * kt + lq) * 144 + 64 + 16 * g);
            f32x4 a = (f32x4){0.f, 0.f, 0.f, 0.f};
            a = __builtin_amdgcn_mfma_f32_16x16x32_bf16(kf0, qf0, a, 0, 0, 0);
            a = __builtin_amdgcn_mfma_f32_16x16x32_bf16(kf1, qf1, a, 0, 0, 0);
            st[kt] = a;
        }
        float tm = -INFINITY;
#pragma unroll
        for (int kt = 0; kt < 8; ++kt)
#pragma unroll
            for (int i = 0; i < 4; ++i) { float s = st[kt][i] * 0.125f; const int jj = 16 * kt + 4 * g + i;
                if (kind == 0 && jj < iq) s = -INFINITY; if (kind == 2 && jj > iq) s = -INFINITY; st[kt][i] = s; tm = fmaxf(tm, s); }
        tm = fmaxf(tm, __shfl_xor(tm, 16)); tm = fmaxf(tm, __shfl_xor(tm, 32));
        const float mn = fmaxf(m, tm), alpha = __expf(m - mn); m = mn;
        float ps = 0.f;
#pragma unroll
        for (int kt = 0; kt < 8; ++kt)
#pragma unroll
            for (int i = 0; i < 4; ++i) { const float p = __expf(st[kt][i] - mn); st[kt][i] = p; ps += p; }
        ps += __shfl_xor(ps, 16); ps += __shfl_xor(ps, 32);
        l = l * alpha + ps;
#pragma unroll
        for (int i = 0; i < 4; ++i) { const float a = __shfl(alpha, 4 * g + i);
#pragma unroll
            for (int dt = 0; dt < 4; ++dt) o[dt][i] *= a; }
#pragma unroll
        for (int tp = 0; tp < 4; ++tp) {
            u32x4 pw; pw.x = cvt_pk(st[2 * tp][0], st[2 * tp][1]); pw.y = cvt_pk(st[2 * tp][2], st[2 * tp][3]); pw.z = cvt_pk(st[2 * tp + 1][0], st[2 * tp + 1][1]); pw.w = cvt_pk(st[2 * tp + 1][2], st[2 * tp + 1][3]);
            const bf16x8 pf = *reinterpret_cast<bf16x8*>(&pw);
#pragma unroll
            for (int dt = 0; dt < 4; ++dt) {
                const s16x4 v0 = __builtin_amdgcn_ds_read_tr16_b64_v4i16((LAS s16x4*)(Vs + (32 * tp + 4 * g + (lq >> 2)) * 144 + (16 * dt + 4 * (lq & 3)) * 2));
                const s16x4 v1 = __builtin_amdgcn_ds_read_tr16_b64_v4i16((LAS s16x4*)(Vs + (32 * tp + 16 + 4 * g + (lq >> 2)) * 144 + (16 * dt + 4 * (lq & 3)) * 2));
                const bf16x8 vf = (bf16x8){v0[0], v0[1], v0[2], v0[3], v1[0], v1[1], v1[2], v1[3]};
                o[dt] = __builtin_amdgcn_mfma_f32_16x16x32_bf16(pf, vf, o[dt], 0, 0, 0);
            }
        }
    }
#pragma unroll
    for (int i = 0; i < 4; ++i) { const float inv = 1.0f / __shfl(l, 4 * g + i);
        bf16_t* op = cat + (qrow0 + wid * 16 + 4 * g + i) * D + 1024 + h * 64 + lq;
#pragma unroll
        for (int dt = 0; dt < 4; ++dt) op[16 * dt] = f2bf(o[dt][i] * inv); }
}

__device__ __forceinline__ void win_attn_item2(char* lds, const bf16_t* __restrict__ P, unsigned char* __restrict__ cat, const float* __restrict__ sink, int b, int kvh, int qb, bool isctx, const int wid0) {
    const int tid = opaque_tid(wid0), wid = tid >> 6, lane = tid & 63, lq = lane & 15, g = lane >> 4;
    const int h = kvh * 8 + wid;
    char* Ks = lds; char* Vs = lds + 64 * 144;
    const size_t qrow0 = isctx ? (size_t)(TL + b * CTXL + qb * 64) : (size_t)(b * SEQ + qb * 64);
    const int q0 = qb * 64;
    bf16x8 qf[4][2];
#pragma unroll
    for (int qt = 0; qt < 4; ++qt) { const bf16_t* qp = P + (qrow0 + 16 * qt + lq) * EVEN_IN + 5120 + h * 64 + 8 * g; qf[qt][0] = *(const bf16x8*)qp; qf[qt][1] = *(const bf16x8*)(qp + 32); }
    float m[4], l[4]; f32x4 o[4][4];
    const float sk = sink[h];
#pragma unroll
    for (int qt = 0; qt < 4; ++qt) { m[qt] = sk; l[qt] = 1.0f;
#pragma unroll
        for (int dt = 0; dt < 4; ++dt) o[qt][dt] = (f32x4){0.f, 0.f, 0.f, 0.f}; }
    const int ntile = isctx ? 4 : 9;
    for (int ti = 0; ti < ntile; ++ti) {
        bool win = false; int kpos0 = 0; size_t krow0;
        if (isctx) krow0 = (size_t)(TL + b * CTXL + ti * 64);
        else if (ti < 5) { win = true; kpos0 = q0 - 128 + 64 * ti; if (kpos0 < 0 || kpos0 >= SEQ) continue; krow0 = (size_t)(b * SEQ + kpos0); }
        else krow0 = (size_t)(TL + b * CTXL + (ti - 5) * 64);
        __syncthreads();
        { const int r = tid >> 3, c = (tid & 7) * 8; const bf16_t* kp = P + (krow0 + r) * EVEN_IN + 6144 + kvh * 64 + c;
          *(bf16x8*)(Ks + r * 144 + c * 2) = *(const bf16x8*)kp; *(bf16x8*)(Vs + r * 144 + c * 2) = *(const bf16x8*)(kp + 128); }
        __syncthreads();
        bf16x8 kf[4][2], vf[2][4];
#pragma unroll
        for (int kt = 0; kt < 4; ++kt) { kf[kt][0] = *(const bf16x8*)(Ks + (16 * kt + lq) * 144 + 16 * g); kf[kt][1] = *(const bf16x8*)(Ks + (16 * kt + lq) * 144 + 64 + 16 * g); }
#pragma unroll
        for (int ks = 0; ks < 2; ++ks)
#pragma unroll
            for (int dt = 0; dt < 4; ++dt) {
                const s16x4 v0 = __builtin_amdgcn_ds_read_tr16_b64_v4i16((LAS s16x4*)(Vs + (32 * ks + 4 * g + (lq >> 2)) * 144 + (16 * dt + 4 * (lq & 3)) * 2));
                const s16x4 v1 = __builtin_amdgcn_ds_read_tr16_b64_v4i16((LAS s16x4*)(Vs + (32 * ks + 16 + 4 * g + (lq >> 2)) * 144 + (16 * dt + 4 * (lq & 3)) * 2));
                vf[ks][dt] = (bf16x8){v0[0], v0[1], v0[2], v0[3], v1[0], v1[1], v1[2], v1[3]}; }
#pragma unroll
        for (int qt = 0; qt < 4; ++qt) {
            f32x4 st[4];
#pragma unroll
            for (int kt = 0; kt < 4; ++kt) { f32x4 a = (f32x4){0.f, 0.f, 0.f, 0.f};
                a = __builtin_amdgcn_mfma_f32_16x16x32_bf16(kf[kt][0], qf[qt][0], a, 0, 0, 0); a = __builtin_amdgcn_mfma_f32_16x16x32_bf16(kf[kt][1], qf[qt][1], a, 0, 0, 0); st[kt] = a; }
            const int qpos = q0 + 16 * qt + lq;
            float tm = -INFINITY;
#pragma unroll
            for (int kt = 0; kt < 4; ++kt)
#pragma unroll
                for (int i = 0; i < 4; ++i) { float sc = st[kt][i] * 0.125f;
                    if (win) { const int d = kpos0 + 16 * kt + 4 * g + i - qpos; if (d < -128 || d > 128) sc = -INFINITY; }
                    st[kt][i] = sc; tm = fmaxf(tm, sc); }
            tm = fmaxf(tm, __shfl_xor(tm, 16)); tm = fmaxf(tm, __shfl_xor(tm, 32));
            const float mn = fmaxf(m[qt], tm), alpha = __expf(m[qt] - mn); m[qt] = mn;
            float ps = 0.f;
#pragma unroll
            for (int kt = 0; kt < 4; ++kt)
#pragma unroll
                for (int i = 0; i < 4; ++i) { const float p = __expf(st[kt][i] - mn); st[kt][i] = p; ps += p; }
            ps += __shfl_xor(ps, 16); ps += __shfl_xor(ps, 32);
            l[qt] = l[qt] * alpha + ps;
#pragma unroll
            for (int i = 0; i < 4; ++i) { const float a = __shfl(alpha, 4 * g + i);
#pragma unroll
                for (int dt = 0; dt < 4; ++dt) o[qt][dt][i] *= a; }
#pragma unroll
            for (int ks = 0; ks < 2; ++ks) {
                u32x4 pw; pw.x = cvt_pk(st[2 * ks][0], st[2 * ks][1]); pw.y = cvt_pk(st[2 * ks][2], st[2 * ks][3]); pw.z = cvt_pk(st[2 * ks + 1][0], st[2 * ks + 1][1]); pw.w = cvt_pk(st[2 * ks + 1][2], st[2 * ks + 1][3]);
                const bf16x8 pf = *reinterpret_cast<bf16x8*>(&pw);
#pragma unroll
                for (int dt = 0; dt < 4; ++dt) o[qt][dt] = __builtin_amdgcn_mfma_f32_16x16x32_bf16(pf, vf[ks][dt], o[qt][dt], 0, 0, 0);
            }
        }
    }
#pragma unroll
    for (int qt = 0; qt < 4; ++qt)
#pragma unroll
        for (int i = 0; i < 4; ++i) { const float inv = 1.0f / __shfl(l[qt], 4 * g + i);
            unsigned char* op = cat + (qrow0 + 16 * qt + 4 * g + i) * D + 1024 + h * 64 + lq;
#pragma unroll
            for (int dt = 0; dt < 4; ++dt) op[16 * dt] = f2fp8(o[qt][dt][i] * inv * 16.0f); }
}

__device__ __forceinline__ float hgrn_lb(const float* __restrict__ lbl, int kk) {
    const float l0 = lbl[kk], l1 = lbl[1024 + kk], l2 = lbl[2048 + kk], mx = fmaxf(l0, fmaxf(l1, l2));
    const float e0 = __expf(l0 - mx), e1 = __expf(l1 - mx), e2 = __expf(l2 - mx);
    return e1 / (e0 + e1 + e2);
}
__device__ __forceinline__ size_t chunk_row0(int b, int ci) { return ci < 64 ? (size_t)(b * SEQ + ci * 64) : (size_t)(TL + b * CTXL + (ci - 64) * 64); }
__device__ __forceinline__ void hgrn_a_item(char* lds, const bf16_t* __restrict__ P, const float* __restrict__ lbl, bf16_t* __restrict__ U, float* __restrict__ DEC, int b, int h, int ci, const int wid0) {
    const int tid = opaque_tid(wid0), wid = tid >> 6, lane = tid & 63, lq = lane & 15, g = lane >> 4;
    const size_t r0 = chunk_row0(b, ci);
    char* WT = lds; char* Vs = lds + 2 * 128 * 144;
    __syncthreads();
    char* FR = lds + 2 * 128 * 144 + 64 * 272;
    {
        const int r = tid >> 3, c = (tid & 7) * 16;
        const bf16_t* vp = P + (r0 + r) * EVEN_IN + 1024 + h * 128 + c;
        const bf16x8 v0 = *(const bf16x8*)vp, v1 = *(const bf16x8*)(vp + 8), a0 = *(const bf16x8*)(vp + 1024), a1 = *(const bf16x8*)(vp + 1032), b0 = *(const bf16x8*)(vp + 2048), b1 = *(const bf16x8*)(vp + 2056);
        *(bf16x8*)(Vs + r * 272 + c * 2) = v0; *(bf16x8*)(Vs + r * 272 + c * 2 + 16) = v1;
        *(bf16x8*)(FR + r * 272 + c * 2) = a0; *(bf16x8*)(FR + r * 272 + c * 2 + 16) = a1;
        *(bf16x8*)(FR + 17408 + r * 272 + c * 2) = b0; *(bf16x8*)(FR + 17408 + r * 272 + c * 2 + 16) = b1;
    }
    __syncthreads();
    {
        const int dir = tid >> 8, k = (tid >> 1) & 127, half = tid & 1, kk = h * 128 + k, s0 = half * 32;
        const float lb = hgrn_lb(lbl, kk);
        const char* fp = FR + dir * 17408 + s0 * 272 + k * 2;
        float f[32], kf[32];
#pragma unroll
        for (int s = 0; s < 32; ++s) f[s] = bf2f(*(const bf16_t*)(fp + s * 272));
        float mine = 0.f;
#pragma unroll
        for (int s = 0; s < 32; ++s) { const float g = lb + (1.0f - lb) * sigmoidf_(f[s]); kf[s] = 1.0f - g; f[s] = __builtin_amdgcn_logf(g); mine += f[s]; }
        const float other = __shfl_xor(mine, 1), tot = mine + other;
        char* wrow = WT + (dir * 128 + k) * 144 + s0 * 2;
        if (dir == 0) {
            float bs = half ? other : 0.f;
#pragma unroll
            for (int s = 0; s < 32; ++s) { bs += f[s]; const float w = kf[s] * __builtin_amdgcn_exp2f(tot - bs); *(bf16_t*)(wrow + s * 2) = f2bf(w); }
        } else {
            float bs = half ? 0.f : other;
#pragma unroll
            for (int s = 31; s >= 0; --s) { bs += f[s]; const float w = kf[s] * __builtin_amdgcn_exp2f(tot - bs); *(bf16_t*)(wrow + s * 2) = f2bf(w); }
        }
        if (half == 0) DEC[((size_t)((b * 8 + h) * 2 + dir) * NCHK + ci) * 128 + k] = __builtin_amdgcn_exp2f(tot);
    }
    __syncthreads();
    bf16x8 vf[2];
#pragma unroll
    for (int ks = 0; ks < 2; ++ks) {
        const s16x4 v0 = __builtin_amdgcn_ds_read_tr16_b64_v4i16((LAS s16x4*)(Vs + (32 * ks + 8 * g + (lq >> 2)) * 272 + (16 * wid + 4 * (lq & 3)) * 2));
        const s16x4 v1 = __builtin_amdgcn_ds_read_tr16_b64_v4i16((LAS s16x4*)(Vs + (32 * ks + 8 * g + 4 + (lq >> 2)) * 272 + (16 * wid + 4 * (lq & 3)) * 2));
        vf[ks] = (bf16x8){v0[0], v0[1], v0[2], v0[3], v1[0], v1[1], v1[2], v1[3]};
    }
#pragma unroll
    for (int dir = 0; dir < 2; ++dir) {
        bf16_t* up = U + (((size_t)((b * 8 + h) * 2 + dir) * NCHK + ci) * 128 + 16 * wid + lq) * 128 + 4 * g;
#pragma unroll
        for (int kt = 0; kt < 8; ++kt) {
            f32x4 a = (f32x4){0.f, 0.f, 0.f, 0.f};
#pragma unroll
            for (int ks = 0; ks < 2; ++ks) { const bf16x8 wf = *(const bf16x8*)(WT + (dir * 128 + 16 * kt + lq) * 144 + (32 * ks + 8 * g) * 2); a = __builtin_amdgcn_mfma_f32_16x16x32_bf16(wf, vf[ks], a, 0, 0, 0); }
            u32x2 w; w.x = cvt_pk(a[0], a[1]); w.y = cvt_pk(a[2], a[3]); *(u32x2*)(up + 16 * kt) = w;
        }
    }
}
__device__ __forceinline__ void hgrn_b_phase(const bf16_t* __restrict__ U, const float* __restrict__ DEC, bf16_t* __restrict__ Sb, const int wid0) {
    for (int idx = blockIdx.x * 512 + opaque_tid(wid0); idx < 64 * 2048; idx += gridDim.x * 512) {
        const int seq = idx >> 11, rem = idx & 2047, v = rem >> 4, k8 = rem & 15, dir = seq & 1;
        float st[8];
#pragma unroll
        for (int j = 0; j < 8; ++j) st[j] = 0.f;
#pragma unroll 4
        for (int p = 0; p < NCHK; ++p) {
            const int ci = dir == 0 ? (p < 4 ? 64 + p : p - 4) : (p < 4 ? 67 - p : 67 - p);
            const size_t cb = (size_t)seq * NCHK + ci, off = (cb * 128 + v) * 128 + k8 * 8;
            const u32x4 u = *(const u32x4*)(U + off);
            const f32x4 d0 = *(const f32x4*)(DEC + cb * 128 + k8 * 8), d1 = *(const f32x4*)(DEC + cb * 128 + k8 * 8 + 4);
            u32x4 sw; sw.x = cvt_pk(st[0], st[1]); sw.y = cvt_pk(st[2], st[3]); sw.z = cvt_pk(st[4], st[5]); sw.w = cvt_pk(st[6], st[7]);
            *(u32x4*)(Sb + off) = sw;
            st[0] = d0[0] * st[0] + bflo(u.x); st[1] = d0[1] * st[1] + bfhi(u.x); st[2] = d0[2] * st[2] + bflo(u.y); st[3] = d0[3] * st[3] + bfhi(u.y);
            st[4] = d1[0] * st[4] + bflo(u.z); st[5] = d1[1] * st[5] + bfhi(u.z); st[6] = d1[2] * st[6] + bflo(u.w); st[7] = d1[3] * st[7] + bfhi(u.w);
        }
    }
}
__device__ __forceinline__ void hgrn_c_item(char* lds, const bf16_t* __restrict__ P, const float* __restrict__ lbl, const bf16_t* __restrict__ Sb, const float* __restrict__ gain, unsigned char* __restrict__ cat, int b, int h, int ci, const int wid0) {
    const int tid = opaque_tid(wid0), wid = tid >> 6, lane = tid & 63, lq = lane & 15, g = lane >> 4;
    const size_t r0 = chunk_row0(b, ci);
    char* QD = lds; char* QA = lds + 34816; char* KA = lds + 69632; char* ATT = lds + 104448; char* Vs = lds + 122880; float* SSW = (float*)(lds + 140288);
    __syncthreads();
    {
        const int r = tid >> 3, c = (tid & 7) * 16;
        const bf16_t* vp = P + (r0 + r) * EVEN_IN + 1024 + h * 128 + c;
        *(bf16x8*)(Vs + r * 272 + c * 2) = *(const bf16x8*)vp; *(bf16x8*)(Vs + r * 272 + c * 2 + 16) = *(const bf16x8*)(vp + 8);
    }
    {
        const int dir = tid >> 8, k = (tid >> 1) & 127, half = tid & 1, kk = h * 128 + k, s0 = half * 32;
        const float lb = hgrn_lb(lbl, kk);
        const bf16_t* fp = P + (r0 + s0) * EVEN_IN + (dir ? 3072 : 2048) + kk;
        const bf16_t* qp = P + (r0 + s0) * EVEN_IN + kk;
        float f[32], kf[32], q[32];
#pragma unroll
        for (int s = 0; s < 32; ++s) { f[s] = bf2f(fp[(size_t)s * EVEN_IN]); q[s] = bf2f(qp[(size_t)s * EVEN_IN]); }
        float mine = 0.f;
#pragma unroll
        for (int s = 0; s < 32; ++s) { const float g = lb + (1.0f - lb) * sigmoidf_(f[s]); kf[s] = 1.0f - g; f[s] = __builtin_amdgcn_logf(g); q[s] = siluf_(q[s]); mine += f[s]; }
        const float other = __shfl_xor(mine, 1);
        char* qd = QD + dir * 17408 + s0 * 272 + k * 2; char* qa = QA + dir * 17408 + s0 * 272 + k * 2; char* ka = KA + dir * 17408 + s0 * 272 + k * 2;
        if (dir == 0) {
            const float bm = half ? other : mine, ebm = __builtin_amdgcn_exp2f(bm); float bs = half ? other : 0.f;
#pragma unroll
            for (int s = 0; s < 32; ++s) { bs += f[s]; const float qe = q[s] * __builtin_amdgcn_exp2f(bs - bm);
                *(bf16_t*)(qd + s * 272) = f2bf(qe * ebm); *(bf16_t*)(qa + s * 272) = f2bf(qe); *(bf16_t*)(ka + s * 272) = f2bf(kf[s] * __builtin_amdgcn_exp2f(bm - bs)); }
        } else {
            const float bm = half ? mine : other, ebm = __builtin_amdgcn_exp2f(bm); float bs = half ? 0.f : other;
#pragma unroll
            for (int s = 31; s >= 0; --s) { bs += f[s]; const float qe = q[s] * __builtin_amdgcn_exp2f(bs - bm);
                *(bf16_t*)(qd + s * 272) = f2bf(qe * ebm); *(bf16_t*)(qa + s * 272) = f2bf(qe); *(bf16_t*)(ka + s * 272) = f2bf(kf[s] * __builtin_amdgcn_exp2f(bm - bs)); }
        }
    }
    __syncthreads();
    {
        const int dir = wid >> 2, tt = wid & 3;
        bf16x8 af[4];
#pragma unroll
        for (int ks = 0; ks < 4; ++ks) af[ks] = *(const bf16x8*)(QA + dir * 17408 + (16 * tt + lq) * 272 + (32 * ks + 8 * g) * 2);
#pragma unroll
        for (int stl = 0; stl < 4; ++stl) {
            f32x4 a = (f32x4){0.f, 0.f, 0.f, 0.f};
            const bool skip = dir == 0 ? (stl > tt) : (stl < tt);
            if (!skip) {
#pragma unroll
                for (int ks = 0; ks < 4; ++ks) { const bf16x8 kf = *(const bf16x8*)(KA + dir * 17408 + (16 * stl + lq) * 272 + (32 * ks + 8 * g) * 2); a = __builtin_amdgcn_mfma_f32_16x16x32_bf16(af[ks], kf, a, 0, 0, 0); }
            }
            const int s = 16 * stl + lq;
#pragma unroll
            for (int i = 0; i < 4; ++i) { const int t = 16 * tt + 4 * g + i; const bool keep = !skip && (dir == 0 ? (s <= t) : (s >= t));
                *(bf16_t*)(ATT + dir * 9216 + t * 144 + s * 2) = keep ? f2bf(a[i]) : (bf16_t)0; }
        }
    }
    __syncthreads();
    f32x4 o[4];
#pragma unroll
    for (int tt = 0; tt < 4; ++tt) o[tt] = (f32x4){0.f, 0.f, 0.f, 0.f};
    bf16x8 vf[2];
#pragma unroll
    for (int ks = 0; ks < 2; ++ks) {
        const s16x4 v0 = __builtin_amdgcn_ds_read_tr16_b64_v4i16((LAS s16x4*)(Vs + (32 * ks + 8 * g + (lq >> 2)) * 272 + (16 * wid + 4 * (lq & 3)) * 2));
        const s16x4 v1 = __builtin_amdgcn_ds_read_tr16_b64_v4i16((LAS s16x4*)(Vs + (32 * ks + 8 * g + 4 + (lq >> 2)) * 272 + (16 * wid + 4 * (lq & 3)) * 2));
        vf[ks] = (bf16x8){v0[0], v0[1], v0[2], v0[3], v1[0], v1[1], v1[2], v1[3]};
    }
#pragma unroll
    for (int dir = 0; dir < 2; ++dir) {
        const bf16_t* sp = Sb + (((size_t)((b * 8 + h) * 2 + dir) * NCHK + ci) * 128 + 16 * wid + lq) * 128 + 8 * g;
        bf16x8 sf[4];
#pragma unroll
        for (int ks = 0; ks < 4; ++ks) sf[ks] = *(const bf16x8*)(sp + 32 * ks);
#pragma unroll
        for (int tt = 0; tt < 4; ++tt) {
#pragma unroll
            for (int ks = 0; ks < 4; ++ks) { const bf16x8 qf = *(const bf16x8*)(QD + dir * 17408 + (16 * tt + lq) * 272 + (32 * ks + 8 * g) * 2); o[tt] = __builtin_amdgcn_mfma_f32_16x16x32_bf16(qf, sf[ks], o[tt], 0, 0, 0); }
#pragma unroll
            for (int ks = 0; ks < 2; ++ks) { const bf16x8 pf = *(const bf16x8*)(ATT + dir * 9216 + (16 * tt + lq) * 144 + (32 * ks + 8 * g) * 2); o[tt] = __builtin_amdgcn_mfma_f32_16x16x32_bf16(pf, vf[ks], o[tt], 0, 0, 0); }
        }
    }
#pragma unroll
    for (int tt = 0; tt < 4; ++tt)
#pragma unroll
        for (int i = 0; i < 4; ++i) { float p = o[tt][i] * o[tt][i]; p += __shfl_xor(p, 1); p += __shfl_xor(p, 2); p += __shfl_xor(p, 4); p += __shfl_xor(p, 8);
            if (lq == 0) SSW[wid * 64 + 16 * tt + 4 * g + i] = p; }
    __syncthreads();
    const float gn = gain[16 * wid + lq];
#pragma unroll
    for (int tt = 0; tt < 4; ++tt)
#pragma unroll
        for (int i = 0; i < 4; ++i) { const int t = 16 * tt + 4 * g + i; float ss = 0.f;
#pragma unroll
            for (int w = 0; w < 8; ++w) ss += SSW[w * 64 + t];
            const float rstd = rsqrtf(ss * (1.0f / 128.0f) + EPS);
            const size_t row = r0 + t; const float graw = bf2f(P[row * EVEN_IN + 4096 + h * 128 + 16 * wid + lq]);
            cat[row * D + h * 128 + 16 * wid + lq] = f2fp8(o[tt][i] * rstd * gn * siluf_(graw)); }
}

__device__ __forceinline__ void norm_mod_rows(const float* __restrict__ src_lat, const float* __restrict__ src_ctx, int nrows, const float* __restrict__ gain,
                                              const float* __restrict__ mods_l, int sh_chunk, int sc_chunk, unsigned char* __restrict__ H, int gw, int NGW, int lane) {
    for (int r = gw; r < nrows; r += NGW) {
        const float* xr = r < TL ? src_lat + (size_t)r * D : src_ctx + (size_t)(r - TL) * D; const int rt = r < TL ? (r >> 12) : 4;
        f32x4 v[8]; float ss = 0.f;
#pragma unroll
        for (int j = 0; j < 8; ++j) { v[j] = *(const f32x4*)(xr + 4 * lane + 256 * j); ss += (v[j][0] * v[j][0] + v[j][1] * v[j][1]) + (v[j][2] * v[j][2] + v[j][3] * v[j][3]); }
        const float rstd = rsqrtf(wave_sum(ss) * (1.0f / D) + EPS);
        const float* mp = mods_l + (size_t)rt * MODW;
#pragma unroll
        for (int j = 0; j < 8; ++j) { const int col = 4 * lane + 256 * j;
            const f32x4 gg = *(const f32x4*)(gain + col), sc = *(const f32x4*)(mp + sc_chunk * D + col), sh = *(const f32x4*)(mp + sh_chunk * D + col);
            const f32x4 y = v[j] * rstd * gg * (sc + 1.0f) + sh;
            int w = 0; w = __builtin_amdgcn_cvt_pk_fp8_f32(y[0], y[1], w, false); w = __builtin_amdgcn_cvt_pk_fp8_f32(y[2], y[3], w, true); *(int*)(H + (size_t)r * D + col) = w; }
    }
}
__device__ __forceinline__ void norm2_router(int nrows, const bf16_t* __restrict__ x1, const float* __restrict__ gain, const float* __restrict__ mods_l, unsigned char* __restrict__ H8,
                                             const bf16_t* __restrict__ wrhi, const bf16_t* __restrict__ wrlo, const float* __restrict__ brt, unsigned* cnt, int* __restrict__ list, float* __restrict__ wts, int* __restrict__ sloti,
                                             char* lds, int vcu, int G, int wid, int lane) {
    const int lq = lane & 15, g = lane >> 4;
    float* ssp = (float*)lds;
    float* plog = (float*)(lds + 1024);
    const float bias = brt[lane];
    for (int tile = vcu; tile < nrows / 32; tile += G) {
        const int row0 = tile * 32; const int rt = row0 < TL ? (row0 >> 12) : 4;
        const int kbase = wid * 256 + 8 * g;
        float ssq[2];
#pragma unroll
        for (int mt = 0; mt < 2; ++mt) { const bf16_t* xr = x1 + (size_t)(row0 + 16 * mt + lq) * D + kbase; float a = 0.f;
#pragma unroll
            for (int ks = 0; ks < 8; ++ks) { const u32x4 w = *(const u32x4*)(xr + 32 * ks);
                const float u0 = bflo(w.x), u1 = bfhi(w.x), u2 = bflo(w.y), u3 = bfhi(w.y), u4 = bflo(w.z), u5 = bfhi(w.z), u6 = bflo(w.w), u7 = bfhi(w.w);
                a += (u0 * u0 + u1 * u1) + (u2 * u2 + u3 * u3) + (u4 * u4 + u5 * u5) + (u6 * u6 + u7 * u7); }
            a += __shfl_xor(a, 16); a += __shfl_xor(a, 32); ssq[mt] = a; }
        __syncthreads();
        if (g == 0) { ssp[wid * 32 + lq] = ssq[0]; ssp[wid * 32 + 16 + lq] = ssq[1]; }
        __syncthreads();
        float rstd[2];
#pragma unroll
        for (int mt = 0; mt < 2; ++mt) { float t = 0.f;
#pragma unroll
            for (int w = 0; w < 8; ++w) t += ssp[w * 32 + 16 * mt + lq];
            rstd[mt] = rsqrtf(t * (1.0f / D) + EPS); }
        const float* mp = mods_l + (size_t)rt * MODW;
        f32x4 acc[2][4];
#pragma unroll
        for (int mt = 0; mt < 2; ++mt)
#pragma unroll
            for (int et = 0; et < 4; ++et) acc[mt][et] = (f32x4){0.f, 0.f, 0.f, 0.f};
#pragma unroll 2
        for (int ks = 0; ks < 8; ++ks) {
            const int col = kbase + 32 * ks;
            f32x4 ga[2], sa[2], ha[2];
#pragma unroll
            for (int q = 0; q < 2; ++q) { ga[q] = *(const f32x4*)(gain + col + 4 * q); sa[q] = *(const f32x4*)(mp + 4 * D + col + 4 * q) + 1.0f; ha[q] = *(const f32x4*)(mp + 3 * D + col + 4 * q); }
            bf16x8 whi[4], wlo[4];
#pragma unroll
            for (int et = 0; et < 4; ++et) { whi[et] = *(const bf16x8*)(wrhi + (size_t)(16 * et + lq) * D + col); wlo[et] = *(const bf16x8*)(wrlo + (size_t)(16 * et + lq) * D + col); }
#pragma unroll
            for (int mt = 0; mt < 2; ++mt) {
                float hv[8]; const u32x4 xw = *(const u32x4*)(x1 + (size_t)(row0 + 16 * mt + lq) * D + col);
#pragma unroll
                for (int q = 0; q < 2; ++q) { const f32x4 xq = q == 0 ? (f32x4){bflo(xw.x), bfhi(xw.x), bflo(xw.y), bfhi(xw.y)} : (f32x4){bflo(xw.z), bfhi(xw.z), bflo(xw.w), bfhi(xw.w)}; const f32x4 y = xq * rstd[mt] * ga[q] * sa[q] + ha[q]; hv[4 * q] = y[0]; hv[4 * q + 1] = y[1]; hv[4 * q + 2] = y[2]; hv[4 * q + 3] = y[3]; }
                { int w0 = 0, w1 = 0; w0 = __builtin_amdgcn_cvt_pk_fp8_f32(hv[0], hv[1], w0, false); w0 = __builtin_amdgcn_cvt_pk_fp8_f32(hv[2], hv[3], w0, true);
                  w1 = __builtin_amdgcn_cvt_pk_fp8_f32(hv[4], hv[5], w1, false); w1 = __builtin_amdgcn_cvt_pk_fp8_f32(hv[6], hv[7], w1, true);
                  u32x2 h8; h8.x = (unsigned)w0; h8.y = (unsigned)w1; *(u32x2*)(H8 + (size_t)(row0 + 16 * mt + lq) * D + col) = h8; }
                u32x4 hw; hw.x = cvt_pk(hv[0], hv[1]); hw.y = cvt_pk(hv[2], hv[3]); hw.z = cvt_pk(hv[4], hv[5]); hw.w = cvt_pk(hv[6], hv[7]);
                u32x4 lw; lw.x = cvt_pk(hv[0] - bflo(hw.x), hv[1] - bfhi(hw.x)); lw.y = cvt_pk(hv[2] - bflo(hw.y), hv[3] - bfhi(hw.y));
                lw.z = cvt_pk(hv[4] - bflo(hw.z), hv[5] - bfhi(hw.z)); lw.w = cvt_pk(hv[6] - bflo(hw.w), hv[7] - bfhi(hw.w));
                const bf16x8 hf = *reinterpret_cast<bf16x8*>(&hw), lf = *reinterpret_cast<bf16x8*>(&lw);
#pragma unroll
                for (int et = 0; et < 4; ++et) {
                    acc[mt][et] = __builtin_amdgcn_mfma_f32_16x16x32_bf16(hf, whi[et], acc[mt][et], 0, 0, 0);
                    acc[mt][et] = __builtin_amdgcn_mfma_f32_16x16x32_bf16(lf, whi[et], acc[mt][et], 0, 0, 0);
                    acc[mt][et] = __builtin_amdgcn_mfma_f32_16x16x32_bf16(hf, wlo[et], acc[mt][et], 0, 0, 0); }
            }
        }
#pragma unroll
        for (int mt = 0; mt < 2; ++mt)
#pragma unroll
            for (int et = 0; et < 4; ++et)
#pragma unroll
                for (int i = 0; i < 4; ++i) plog[(wid * 32 + 16 * mt + 4 * g + i) * 64 + 16 * et + lq] = acc[mt][et][i];
        __syncthreads();
        float tot[4];
#pragma unroll
        for (int j = 0; j < 4; ++j) { const int idx = (wid * 64 + lane) * 4 + j; float sm = 0.f;
#pragma unroll
            for (int w = 0; w < 8; ++w) sm += plog[w * 2048 + idx];
            tot[j] = sm; }
        __syncthreads();
#pragma unroll
        for (int j = 0; j < 4; ++j) plog[(wid * 64 + lane) * 4 + j] = tot[j];
        __syncthreads();
        {
            float s4[4], cand4[4], w4[4]; int myk4[4];
#pragma unroll
            for (int rr = 0; rr < 4; ++rr) {
                const float logit = plog[(wid * 4 + rr) * 64 + lane];
                const float sg = 1.0f / (1.0f + expf(-logit)), bsd = sg + bias;
                float m1 = bsd; m1 = fmaxf(m1, __shfl_xor(m1, 1)); m1 = fmaxf(m1, __shfl_xor(m1, 2)); m1 = fmaxf(m1, __shfl_xor(m1, 4));
                const unsigned long long bal = __ballot(bsd == m1); const int gbase = lane & ~7; const unsigned gb = (unsigned)(bal >> gbase) & 0xffu; const int first = gbase + __ffs(gb) - 1;
                float m2 = (lane == first) ? -INFINITY : bsd; m2 = fmaxf(m2, __shfl_xor(m2, 1)); m2 = fmaxf(m2, __shfl_xor(m2, 2)); m2 = fmaxf(m2, __shfl_xor(m2, 4));
                const float gs = m1 + m2; int rank = 0;
#pragma unroll
                for (int j = 0; j < 8; ++j) { const float gj = __shfl(gs, 8 * j); rank += (gj > gs || (gj == gs && j < (lane >> 3))) ? 1 : 0; }
                s4[rr] = sg; cand4[rr] = rank < 4 ? bsd : -INFINITY; myk4[rr] = -1; }
#pragma unroll
            for (int k = 0; k < 8; ++k)
#pragma unroll
                for (int rr = 0; rr < 4; ++rr) { float mm = cand4[rr];
#pragma unroll
                    for (int o = 1; o < 64; o <<= 1) mm = fmaxf(mm, __shfl_xor(mm, o));
                    const unsigned long long bb = __ballot(cand4[rr] == mm); const int win = __ffsll((long long)bb) - 1;
                    if (lane == win) { myk4[rr] = k; cand4[rr] = -INFINITY; } }
#pragma unroll
            for (int rr = 0; rr < 4; ++rr) { const float wsum = wave_sum(myk4[rr] >= 0 ? s4[rr] : 0.f); w4[rr] = s4[rr] / wsum * 2.5f; }
            unsigned pos4[4];
#pragma unroll
            for (int rr = 0; rr < 4; ++rr) pos4[rr] = myk4[rr] >= 0 ? atomicAdd(cnt + lane * 64, 1u) : 0u;
#pragma unroll
            for (int rr = 0; rr < 4; ++rr) if (myk4[rr] >= 0) { const int rloc = wid * 4 + rr, aid = (row0 + rloc) * 8 + myk4[rr];
                list[(size_t)lane * TA + pos4[rr]] = row0 + rloc; sloti[aid] = (lane << 20) | (int)pos4[rr]; wts[aid] = w4[rr]; }
        }
    }
}
__device__ __forceinline__ void combine_rows(int nrows, bf16_t* __restrict__ x1, const unsigned char* __restrict__ Y, const float* __restrict__ wts, const int* __restrict__ sloti, const int* tstart, const float* __restrict__ mods_l,
                                             const float* __restrict__ gain_n, const float* __restrict__ mods_n, unsigned char* __restrict__ H, float* __restrict__ outp, int gw, int NGW, int lane) {
    for (int r = gw; r < nrows; r += NGW) {
        const int rt = r < TL ? (r >> 12) : 4;
        float acc[4][8];
#pragma unroll
        for (int j = 0; j < 4; ++j)
#pragma unroll
            for (int e = 0; e < 8; ++e) acc[j][e] = 0.f;
        int myrow; float myw;
        { const int kq = lane & 7; const int info = sloti[(size_t)r * 8 + kq]; myrow = tstart[info >> 20] * 256 + (info & 0xfffff); myw = wts[(size_t)r * 8 + kq]; }
#pragma unroll 3
        for (int k = 0; k < 9; ++k) { const size_t srow = k < 8 ? (size_t)__shfl(myrow, k) : (size_t)tstart[64] * 256 + r; const float w = k < 8 ? __shfl(myw, k) : 1.0f;
#pragma unroll
            for (int j = 0; j < 4; ++j) { const u32x2 v = *(const u32x2*)(Y + srow * D + 8 * lane + 512 * j);
                const f32x2 a0 = __builtin_amdgcn_cvt_pk_f32_fp8((int)v.x, false), a1 = __builtin_amdgcn_cvt_pk_f32_fp8((int)v.x, true), a2 = __builtin_amdgcn_cvt_pk_f32_fp8((int)v.y, false), a3 = __builtin_amdgcn_cvt_pk_f32_fp8((int)v.y, true);
                acc[j][0] += w * a0[0]; acc[j][1] += w * a0[1]; acc[j][2] += w * a1[0]; acc[j][3] += w * a1[1]; acc[j][4] += w * a2[0]; acc[j][5] += w * a2[1]; acc[j][6] += w * a3[0]; acc[j][7] += w * a3[1]; } }
        float ss = 0.f; const float* mp = mods_l + (size_t)rt * MODW + 5 * D;
#pragma unroll
        for (int j = 0; j < 4; ++j) { const int col = 8 * lane + 512 * j; bf16_t* xp = x1 + (size_t)r * D + col;
            const u32x4 xw = *(const u32x4*)xp; const float xv[8] = {bflo(xw.x), bfhi(xw.x), bflo(xw.y), bfhi(xw.y), bflo(xw.z), bfhi(xw.z), bflo(xw.w), bfhi(xw.w)};
            const f32x4 g2a = *(const f32x4*)(mp + col), g2b = *(const f32x4*)(mp + col + 4);
#pragma unroll
            for (int e = 0; e < 8; ++e) { const float y = xv[e] + (e < 4 ? g2a[e & 3] : g2b[e & 3]) * acc[j][e]; acc[j][e] = y; ss += y * y; }
            if (!outp) { u32x4 o; o.x = cvt_pk(acc[j][0], acc[j][1]); o.y = cvt_pk(acc[j][2], acc[j][3]); o.z = cvt_pk(acc[j][4], acc[j][5]); o.w = cvt_pk(acc[j][6], acc[j][7]); *(u32x4*)xp = o; } }
        const float rstd = rsqrtf(wave_sum(ss) * (1.0f / D) + EPS);
        if (outp) {
#pragma unroll
            for (int j = 0; j < 4; ++j)
#pragma unroll
                for (int q = 0; q < 2; ++q) { const int col = 8 * lane + 512 * j + 4 * q; const f32x4 gg = *(const f32x4*)(gain_n + col); f32x4 y;
#pragma unroll
                    for (int e = 0; e < 4; ++e) y[e] = acc[j][4 * q + e] * rstd * gg[e];
                    *(f32x4*)(outp + (size_t)r * D + col) = y; }
        } else {
            const float* mn = mods_n + (size_t)rt * MODW;
#pragma unroll
            for (int j = 0; j < 4; ++j) { const int col = 8 * lane + 512 * j; float y[8];
#pragma unroll
                for (int q = 0; q < 2; ++q) { const f32x4 gg = *(const f32x4*)(gain_n + col + 4 * q), sc = *(const f32x4*)(mn + 1 * D + col + 4 * q), sh = *(const f32x4*)(mn + col + 4 * q);
#pragma unroll
                    for (int e = 0; e < 4; ++e) y[4 * q + e] = acc[j][4 * q + e] * rstd * gg[e] * (1.0f + sc[e]) + sh[e]; }
                int w0 = 0, w1 = 0; w0 = __builtin_amdgcn_cvt_pk_fp8_f32(y[0], y[1], w0, false); w0 = __builtin_amdgcn_cvt_pk_fp8_f32(y[2], y[3], w0, true); w1 = __builtin_amdgcn_cvt_pk_fp8_f32(y[4], y[5], w1, false); w1 = __builtin_amdgcn_cvt_pk_fp8_f32(y[6], y[7], w1, true);
                u32x2 w; w.x = (unsigned)w0; w.y = (unsigned)w1; *(u32x2*)(H + (size_t)r * D + col) = w; }
        }
    }
}
__device__ __forceinline__ void rope_norm32(const bf16_t* __restrict__ src, unsigned char* __restrict__ dst8, int krow, const float* __restrict__ gn, const float* __restrict__ tab, int lane4, bool rope, int posr, int posc) {
    u32x4 w[4]; float x[32]; float ss = 0.f;
#pragma unroll
    for (int j = 0; j < 4; ++j) { w[j] = *(const u32x4*)(src + 8 * j);
        x[8 * j] = bflo(w[j].x); x[8 * j + 1] = bfhi(w[j].x); x[8 * j + 2] = bflo(w[j].y); x[8 * j + 3] = bfhi(w[j].y); x[8 * j + 4] = bflo(w[j].z); x[8 * j + 5] = bfhi(w[j].z); x[8 * j + 6] = bflo(w[j].w); x[8 * j + 7] = bfhi(w[j].w); }
#pragma unroll
    for (int e = 0; e < 32; ++e) ss += x[e] * x[e];
    ss += __shfl_xor(ss, 1); ss += __shfl_xor(ss, 2);
    const float rstd = rsqrtf(ss * (1.0f / 128.0f) + EPS);
    const int p0 = lane4 * 32, hf = p0 >> 6; const int pos = hf ? posc : posr;
#pragma unroll
    for (int e = 0; e < 32; e += 2) { const int j = ((p0 + e) & 63) >> 1;
        const float y1 = x[e] * rstd * gn[64 * hf + j], y2 = x[e + 1] * rstd * gn[64 * hf + 32 + j];
        float c = 1.f, s = 0.f; if (rope) { c = tab[pos * 32 + j]; s = tab[2048 + pos * 32 + j]; }
        x[e] = y1 * c - y2 * s; x[e + 1] = y2 * c + y1 * s; }
#pragma unroll
    for (int j = 0; j < 4; ++j) { const int p = p0 + 8 * j, byte = ((p >> 3) & 1) * 64 + (p >> 4) * 8;
        int wa = 0, wb = 0; wa = __builtin_amdgcn_cvt_pk_fp8_f32(x[8 * j], x[8 * j + 1], wa, false); wa = __builtin_amdgcn_cvt_pk_fp8_f32(x[8 * j + 2], x[8 * j + 3], wa, true);
        wb = __builtin_amdgcn_cvt_pk_fp8_f32(x[8 * j + 4], x[8 * j + 5], wb, false); wb = __builtin_amdgcn_cvt_pk_fp8_f32(x[8 * j + 6], x[8 * j + 7], wb, true);
        u32x2 o; o.x = (unsigned)wa; o.y = (unsigned)wb; *(u32x2*)(dst8 + ga::k8_off(krow, byte >> 4) + (byte & 15)) = o; }
}
__device__ __forceinline__ void post_odd(const bf16_t* __restrict__ PO, const float* __restrict__ gk, const float* __restrict__ tab,
                                         unsigned char* __restrict__ K8, unsigned char* __restrict__ VT8, char* lds, int vcu, int G, int gw, int NGW, int tid, int lane) {
    const int l32 = lane & 31;
    for (int r = 2 * gw + (lane >> 5); r < TA; r += 2 * NGW) {
        const bool lat = r < TL; int b, kp, posr = 0, posc = 0;
        if (lat) { b = r >> 12; const int t = r & (SEQ - 1); kp = CTXL + t; posr = t >> 6; posc = t & 63; } else { b = (r - TL) >> 8; kp = (r - TL) & (CTXL - 1); }
        const bf16_t* pr = PO + (size_t)r * ODD_IN;
        if (l32 < 16) rope_norm32(pr + 2048 + 32 * l32, K8 + (size_t)(((b * 4 + (l32 >> 2)) * 68) + (kp >> 6)) * 8192, kp & 63, gk, tab, l32 & 3, lat, posr, posc);
    }
    for (int tl = vcu; tl < NBATCH * 4 * 68; tl += G) {
        const int t68 = tl % 68, kvh = (tl / 68) & 3, b = tl / (68 * 4);
        const int k = tid >> 3, c = (tid & 7) * 16, kp = 64 * t68 + k;
        const size_t row = kp < CTXL ? (size_t)(TL + b * CTXL + kp) : (size_t)(b * SEQ + kp - CTXL);
        const bf16_t* vp = PO + row * ODD_IN + 2560 + kvh * 128 + c;
        const u32x2 f0 = ga::k8pack(*(const bf16x8*)vp), f1 = ga::k8pack(*(const bf16x8*)(vp + 8));
        __syncthreads();
        const int pos = ga::vt_pos(k);
#pragma unroll
        for (int e = 0; e < 16; ++e) { const unsigned w = e < 4 ? f0.x : e < 8 ? f0.y : e < 12 ? f1.x : f1.y; lds[ga::vt_off(c + e, pos)] = (char)((w >> (8 * (e & 3))) & 0xff); }
        __syncthreads();
        *(u32x4*)(VT8 + (size_t)tl * 8192 + tid * 16) = *(const u32x4*)(lds + tid * 16);
    }
}

__device__ __forceinline__ int dest_row(int n, int map) {
    if (map == 0) return n;
    if (map == 1) return (n >> 7) * 256 + (n & 127);
    if (map == 2) return (n >> 7) * 256 + 128 + (n & 127);
    if (n >= 2560) return n;
    const int head = n >> 7, i = n & 127, hf = i >> 6, ii = i & 63, part = ii >> 5, j = ii & 31;
    return head * 128 + hf * 64 + 2 * j + part;
}
struct TItem { const float* src; unsigned char* dst; int ldw, K, map, fp8; float scale; };
__device__ __forceinline__ void titem_load(const TItem& t, f32x4 (&v)[8], int lane) {
#pragma unroll
    for (int i = 0; i < 8; ++i) v[i] = __builtin_nontemporal_load((const f32x4*)(t.src + (size_t)(8 * (lane >> 3) + i) * t.ldw + 4 * (lane & 7)));
}
__device__ __forceinline__ void titem_store(const TItem& t, const f32x4 (&v)[8], int n0, int lane) {
    const int kq = 8 * (lane >> 3);
#pragma unroll
    for (int e = 0; e < 4; ++e) { const size_t drow = (size_t)dest_row(n0 + 4 * (lane & 7) + e, t.map);
        if (t.fp8) { int w0 = 0, w1 = 0;
            w0 = __builtin_amdgcn_cvt_pk_fp8_f32(v[0][e] * t.scale, v[1][e] * t.scale, w0, false); w0 = __builtin_amdgcn_cvt_pk_fp8_f32(v[2][e] * t.scale, v[3][e] * t.scale, w0, true);
            w1 = __builtin_amdgcn_cvt_pk_fp8_f32(v[4][e] * t.scale, v[5][e] * t.scale, w1, false); w1 = __builtin_amdgcn_cvt_pk_fp8_f32(v[6][e] * t.scale, v[7][e] * t.scale, w1, true);
            u32x2 o; o.x = (unsigned)w0; o.y = (unsigned)w1; *(u32x2*)(t.dst + drow * t.K + kq) = o;
        } else { u32x4 o; o.x = cvt_pk(v[0][e], v[1][e]); o.y = cvt_pk(v[2][e], v[3][e]); o.z = cvt_pk(v[4][e], v[5][e]); o.w = cvt_pk(v[6][e], v[7][e]); *(u32x4*)(t.dst + (drow * t.K + kq) * 2) = o; }
    }
}

struct Args { const float* in[26]; float* out; unsigned char* ws; int ph_lo, ph_hi; };
constexpr int NPHASE = 19;
#ifndef PHMASK
#define PHMASK 0xFFFFFFFFu
#endif
#define SITE(n) ((PHMASK >> (n)) & 1u)
__device__ __forceinline__ unsigned char* opq(unsigned char* p) { asm volatile("" : "+s"(p)); return p; }
__device__ __forceinline__ const float* opq(const float* p) { asm volatile("" : "+s"(p)); return p; }
__device__ __forceinline__ int opqi(int v) { asm volatile("" : "+s"(v)); return v; }
#define CAS __attribute__((address_space(4)))
__device__ __forceinline__ const CAS unsigned char* kargs() { const CAS unsigned char* p = (const CAS unsigned char*)__builtin_amdgcn_kernarg_segment_ptr(); asm volatile("" : "+s"(p)); return p; }
static_assert(sizeof(Args) == 232 && offsetof(Args, out) == 208 && offsetof(Args, ws) == 216 && offsetof(Args, ph_lo) == 224, "Args layout");
#define INP(k) (*(const float* const CAS*)(kargs() + 8 * (k)))
#define OUTP() (*(float* const CAS*)(kargs() + 208))
#define WSP(T, off) ((T*)(*(unsigned char* const CAS*)(kargs() + 216) + (off)))
#define PH_LO() (*(const int CAS*)(kargs() + 224))
#define PH_HI() (*(const int CAS*)(kargs() + 228))
#define IN(k) (PH_LO() <= (k) && (k) < PH_HI())

constexpr int T_ND = 13568, T_NX1 = 195 * 512;
#define TDESC(it_, t_, n0_) do { const int it__ = (it_); int kb_, nb_; \
        if (it__ < 6400) { kb_ = it__ / 200; nb_ = it__ % 200; t_.src = INP(8); t_.ldw = EVEN_IN; t_.K = D; t_.dst = WSP(unsigned char, WS_WINE); t_.map = 0; t_.fp8 = 1; t_.scale = 64.f; } \
        else if (it__ < 8448) { const int r_ = it__ - 6400; kb_ = r_ / 64; nb_ = r_ % 64; t_.src = INP(9); t_.ldw = D; t_.K = D; t_.dst = WSP(unsigned char, WS_WOUTE); t_.map = 0; t_.fp8 = 1; t_.scale = 64.f; } \
        else if (it__ < 11520) { const int r_ = it__ - 8448; kb_ = r_ / 96; nb_ = r_ % 96; t_.src = INP(13); t_.ldw = ODD_IN; t_.K = D; t_.dst = WSP(unsigned char, WS_WINO); t_.map = 3; t_.fp8 = 1; t_.scale = 64.f; } \
        else if (it__ < T_ND) { const int r_ = it__ - 11520; kb_ = r_ / 64; nb_ = r_ % 64; t_.src = INP(14); t_.ldw = D; t_.K = D; t_.dst = WSP(unsigned char, WS_WOUTO); t_.map = 0; t_.fp8 = 1; t_.scale = 64.f; } \
        else { const int r_ = it__ - T_ND, qq_ = r_ >> 9, w_ = r_ & 511, l_ = qq_ / 195, rem_ = qq_ % 195, e_ = rem_ / 3, mat_ = rem_ % 3; t_.fp8 = 1; \
            if (mat_ < 2) { kb_ = w_ >> 4; nb_ = w_ & 15; t_.src = e_ < 64 ? (mat_ == 0 ? INP(19) : INP(20)) + ((size_t)(l_ * 64 + e_)) * D * DEXP : (mat_ == 0 ? INP(22) : INP(23)) + (size_t)l_ * D * DEXP; \
                t_.ldw = DEXP; t_.K = D; t_.dst = WSP(unsigned char, WS_WGU) + ((size_t)(l_ * 65 + e_)) * 1024 * D; t_.map = 1 + mat_; t_.scale = 64.f; } \
            else { kb_ = w_ >> 6; nb_ = w_ & 63; t_.src = e_ < 64 ? INP(21) + ((size_t)(l_ * 64 + e_)) * DEXP * D : INP(24) + (size_t)l_ * DEXP * D; \
                t_.ldw = D; t_.K = DEXP; t_.dst = WSP(unsigned char, WS_WDN) + ((size_t)(l_ * 65 + e_)) * D * DEXP; t_.map = 0; t_.scale = 32.f; } } \
        t_.src += (size_t)(64 * kb_) * t_.ldw + 32 * nb_; t_.dst += (size_t)(64 * kb_) * (t_.fp8 ? 1 : 2); n0_ = 32 * nb_; } while (0)
struct Geo { int tid, lane, wid, G, bx, vcu, gw, NGW; };
__device__ __forceinline__ Geo geo(const int wid0) { Geo g; g.tid = opaque_tid(wid0); g.lane = g.tid & 63; g.wid = __builtin_amdgcn_readfirstlane(g.tid >> 6); g.G = gridDim.x; g.bx = blockIdx.x;
    g.vcu = (g.G % 8 == 0) ? (g.bx % 8) * (g.G / 8) + g.bx / 8 : g.bx; g.gw = g.vcu * NWAVES + g.wid; g.NGW = g.G * NWAVES; return g; }

__device__ __forceinline__ void phase_prologue(const Args& args, LAS unsigned char* ldsl, char* ldsg, const int wid0) {
    const Geo q = geo(wid0); const int tid = q.tid, lane = q.lane, wid = q.wid, G = q.G, bx = q.bx;
    for (int ait = bx; ait < 192; ait += G) {
        const float* c_in = INP(1); const float* cctx_in = INP(3); const float* w_ada = INP(4); const float* b_ada = INP(5); float* mods = WSP(float, WS_MODS);
        float* sl = (float*)ldsg; float* red = (float*)(ldsg + 40960);
        for (int i = tid; i < 5 * D; i += 512) { const int r = i >> 11, k = i & (D - 1); const float cv = r < 4 ? c_in[r * D + k] : cctx_in[k]; sl[i] = cv / (1.0f + expf(-cv)); }
        __syncthreads();
        const int l = ait / 96, n0 = (ait % 96) * 128, cg = tid & 31, kg = tid >> 5;
        f32x4 acc[5];
#pragma unroll
        for (int r = 0; r < 5; ++r) acc[r] = (f32x4){0.f, 0.f, 0.f, 0.f};
        const float* wp = w_ada + ((size_t)l * D + kg * 128) * MODW + n0 + 4 * cg;
#pragma unroll 8
        for (int k = 0; k < 128; ++k) { const f32x4 w = *(const f32x4*)(wp + (size_t)k * MODW);
#pragma unroll
            for (int r = 0; r < 5; ++r) acc[r] += w * sl[r * D + kg * 128 + k]; }
#pragma unroll
        for (int r = 0; r < 5; ++r) *(f32x4*)(red + (kg * 5 + r) * 128 + 4 * cg) = acc[r];
        __syncthreads();
        if (tid < 160) { const int r = tid >> 5; f32x4 sm = *(const f32x4*)(b_ada + (size_t)l * MODW + n0 + 4 * cg);
            for (int k2 = 0; k2 < 16; ++k2) sm += *(const f32x4*)(red + (k2 * 5 + r) * 128 + 4 * cg);
            *(f32x4*)(mods + ((size_t)l * 5 + r) * MODW + n0 + 4 * cg) = sm; }
        __syncthreads();
    }
    if (bx == G - 1) {
        float* tab = WSP(float, WS_TAB);
        for (int i = tid; i < 64 * 16; i += 512) { const int pos = i >> 4, j = i & 15; const float fr = expf(-9.210340371976184f * (float)j / 16.0f), a = (float)pos * fr; tab[i] = cosf(a); tab[1024 + i] = sinf(a); }
        for (int i = tid; i < 64 * 32; i += 512) { const int pos = i >> 5, j = i & 31; const float fr = expf(-9.210340371976184f * (float)j / 32.0f), a = (float)pos * fr; tab[2048 + i] = cosf(a); tab[4096 + i] = sinf(a); }
    }
    { const float* w_router = INP(17); bf16_t* wr_hi = WSP(bf16_t, WS_WR); bf16_t* wr_lo = wr_hi + 2 * 64 * 2048;
      for (int i = bx * 512 + tid; i < 2 * 64 * 2048; i += G * 512) {
        const int l = i >> 17, e = (i >> 11) & 63, k = i & 2047; const float w = w_router[((size_t)l * D + k) * 64 + e];
        const bf16_t hi16 = f2bf(w); wr_hi[i] = hi16; wr_lo[i] = f2bf(w - bf2f(hi16)); } }
    const int NIT = (PH_HI() - PH_LO() > 1) ? T_ND : T_ND + 2 * T_NX1;
    int it = q.gw;
    if (it < NIT) {
        TItem ta, tb; int na, nb2; f32x4 va[8], vb[8];
        TDESC(it, ta, na); titem_load(ta, va, lane);
        for (;;) {
            int nx = it + q.NGW;
            if (nx < NIT) { TDESC(nx, tb, nb2); titem_load(tb, vb, lane); }
            titem_store(ta, va, na, lane);
            if (nx >= NIT) break;
            it = nx; nx = it + q.NGW;
            if (nx < NIT) { TDESC(nx, ta, na); titem_load(ta, va, lane); }
            titem_store(tb, vb, nb2, lane);
            if (nx >= NIT) break;
            it = nx;
        }
    }
    __syncthreads();
}
template <int L> __device__ __forceinline__ void phase_inproj(const Args& args, LAS unsigned char* ldsl, const int wid0) {
    pg8::DenseSched S; S.init(TA, L == 0 ? EVEN_IN : ODD_IN, D / 2, gridDim.x, blockIdx.x, WSP(unsigned char, L == 0 ? WS_WINE : WS_WINO));
    pg8::EpiProj E{WSP(bf16_t, L == 0 ? WS_PE : WS_PO), L == 0 ? EVEN_IN : ODD_IN, L == 0 ? 20 : 0, L == 0 ? 24 : 0, L == 0 ? 24 : -1, WSP(float, WS_TAB)};
    pg8::gemm_phase<pg8::EpiProj, pg8::DenseSched, true, 127 - 6>(ldsl, (const char*)WSP(unsigned char, WS_H), D / 2, S, E, wid0);
}
template <int L> __device__ __forceinline__ void phase_outproj(const Args& args, LAS unsigned char* ldsl, const int wid0) {
    constexpr int T = L == 0 ? TA : TL;
    pg8::DenseSched S; S.init(T, D, D / 2, gridDim.x, blockIdx.x, WSP(unsigned char, L == 0 ? WS_WOUTE : WS_WOUTO));
    pg8::EpiOutRes<L != 0> E{INP(0), INP(2), WSP(bf16_t, WS_X1), WSP(float, WS_MODS) + (size_t)L * 5 * MODW + 2 * D};
    pg8::gemm_phase<pg8::EpiOutRes<L != 0>, pg8::DenseSched, true, 127 - 6>(ldsl, (const char*)WSP(unsigned char, WS_CAT), D / 2, S, E, wid0);
}
template <int L> __device__ __forceinline__ void phase_router(const Args& args, char* ldsg, const int wid0) {
    constexpr int T = L == 0 ? TA : TL; const Geo q = geo(wid0);
    bf16_t* wr_hi = WSP(bf16_t, WS_WR);
    norm2_router(T, WSP(bf16_t, WS_X1), INP(7) + (size_t)L * D, WSP(float, WS_MODS) + (size_t)L * 5 * MODW, WSP(unsigned char, WS_H8), wr_hi + (size_t)L * 64 * D, wr_hi + (size_t)(2 + L) * 64 * D, INP(18) + L * 64,
                 WSP(unsigned, WS_CTL) + CW_CNT + L * 64 * 64, WSP(int, WS_LIST), WSP(float, WS_WTS), WSP(int, WS_SLOTI), ldsg, q.vcu, q.G, q.wid, q.lane);
}
template <int L> __device__ __forceinline__ void moe_tables(const Args& args, LAS unsigned char* ldsl, int NT, int tid) {
    constexpr int T = L == 0 ? TA : TL;
    LAS int* ustart = (LAS int*)(ldsl + MISC_OFF + 64 * 4); LAS int* ecnt = (LAS int*)(ldsl + MISC_OFF + 192 * 4); LAS int* tstart = (LAS int*)(ldsl + MISC_OFF + 320 * 4);
    unsigned* cnt = WSP(unsigned, WS_CTL) + CW_CNT + L * 64 * 64;
    __syncthreads();
    if (tid < 65) ecnt[tid] = tid < 64 ? (int)__hip_atomic_load(cnt + tid * 64, __ATOMIC_RELAXED, __HIP_MEMORY_SCOPE_AGENT) : T;
    __syncthreads();
    if (tid == 0) { int su = 0, st = 0; for (int e = 0; e < 65; ++e) { ustart[e] = su; tstart[e] = st; const int nt = (ecnt[e] + 255) >> 8; su += nt * NT; st += nt; } ustart[65] = su; tstart[65] = st; }
    __syncthreads();
}
template <int L, int MODE> __device__ __forceinline__ void phase_moe(const Args& args, LAS unsigned char* ldsl, const int wid0) {
    constexpr int NT = MODE == 0 ? 4 : 8; const Geo q = geo(wid0);
    moe_tables<L>(args, ldsl, NT, q.tid);
    LAS int* ustart = (LAS int*)(ldsl + MISC_OFF + 64 * 4); LAS int* ecnt = (LAS int*)(ldsl + MISC_OFF + 192 * 4); LAS int* tstart = (LAS int*)(ldsl + MISC_OFF + 320 * 4);
    pg8::MoeSched S; S.ustart = ustart; S.ecnt = ecnt; S.tstart = tstart; S.total = ustart[65]; S.G = q.G; S.c = q.vcu; S.NT = NT; S.mode = MODE; S.list = WSP(int, WS_LIST);
    if constexpr (MODE == 0) { S.Bt = (const char*)(WSP(unsigned char, WS_WGU) + (size_t)L * 65 * 1024 * D); S.estepB = (size_t)1024 * D; S.tstepB = (size_t)256 * D;
        pg8::EpiGateUp E{WSP(unsigned char, WS_HID)};
        pg8::gemm_phase<pg8::EpiGateUp, pg8::MoeSched, true, 127 - 6>(ldsl, (const char*)WSP(unsigned char, WS_H8), D / 2, S, E, wid0);
    } else { S.Bt = (const char*)(WSP(unsigned char, WS_WDN) + (size_t)L * 65 * D * DEXP); S.estepB = (size_t)D * DEXP; S.tstepB = (size_t)256 * DEXP;
        pg8::EpiDown E{WSP(unsigned char, WS_Y)};
        pg8::gemm_phase<pg8::EpiDown, pg8::MoeSched, true, 127 - 5>(ldsl, (const char*)WSP(unsigned char, WS_HID), DEXP / 2, S, E, wid0);
    }
}
template <int L> __device__ __forceinline__ void phase_combine(const Args& args, LAS unsigned char* ldsl, char* ldsg, const int wid0) {
    constexpr int T = L == 0 ? TA : TL; const Geo q = geo(wid0);
    moe_tables<L>(args, ldsl, 1, q.tid);
    float* mods = WSP(float, WS_MODS);
    combine_rows(T, WSP(bf16_t, WS_X1), WSP(unsigned char, WS_Y), WSP(float, WS_WTS), WSP(int, WS_SLOTI), (const int*)(ldsg + MISC_OFF + 320 * 4), mods + (size_t)L * 5 * MODW, L == 0 ? INP(6) + D : INP(25), mods + (size_t)5 * MODW, WSP(unsigned char, WS_H), L == 0 ? nullptr : OUTP(), q.gw, q.NGW, q.lane);
}

constexpr unsigned Q_A = 2 * 65 * 512 / 16, Q_B = 3 * 65 * 512 / 16, Q_ALL = 2 * 3 * 65 * 512 / 16;
__device__ __forceinline__ int queue_item(unsigned p) {
    if (p < 2u * 65u * 512u) { const unsigned qa = p >> 9; return T_ND + (int)((((qa >> 1) * 3u + (qa & 1u)) << 9) | (p & 511u)); }
    if (p < 3u * 65u * 512u) { const unsigned pb = p - 2u * 65u * 512u; return T_ND + (int)((((pb >> 9) * 3u + 2u) << 9) | (pb & 511u)); }
    return T_ND + (int)p;
}
__device__ __forceinline__ void steal_convert(unsigned* ctl, int seam, unsigned drain_to, volatile LAS unsigned* MISC, const int wid0) {
    const int tid = opaque_tid(wid0), lane = tid & 63, wid = __builtin_amdgcn_readfirstlane(tid >> 6);
    if (MISC[18] != 0u) return;
    if (tid == 0) __hip_atomic_fetch_add(ctl + CW_ARR + seam * 64, 1u, __ATOMIC_RELAXED, __HIP_MEMORY_SCOPE_AGENT);
    unsigned last = 0u;
#define STEAL_CLAIM(stop_, c_) do { __syncthreads(); if (tid == 0) { unsigned st_ = 0u, cc_ = 0u; \
        const bool all_here_ = __hip_atomic_load(ctl + CW_ARR + seam * 64, __ATOMIC_RELAXED, __HIP_MEMORY_SCOPE_AGENT) >= gridDim.x; \
        if (all_here_ && last >= drain_to) st_ = 1u; \
        else { cc_ = __hip_atomic_fetch_add(ctl + CW_Q, 1u, __ATOMIC_RELAXED, __HIP_MEMORY_SCOPE_AGENT); if (cc_ >= Q_ALL) { st_ = 1u; MISC[18] = 1u; } } \
        MISC[16] = st_; MISC[17] = cc_; } \
        __syncthreads(); stop_ = MISC[16]; c_ = MISC[17]; if (!stop_) last = c_ + 1u; } while (0)
#define STEAL_LOAD(c_, t0_, t1_, n0_, n1_, v0_, v1_) do { TDESC(queue_item((c_) * 16u + (unsigned)wid), t0_, n0_); titem_load(t0_, v0_, lane); TDESC(queue_item((c_) * 16u + 8u + (unsigned)wid), t1_, n1_); titem_load(t1_, v1_, lane); } while (0)
    TItem ta0, ta1, tb0, tb1; int na0, na1, nb0, nb1; f32x4 va0[8], va1[8], vb0[8], vb1[8];
    unsigned stop, c;
    STEAL_CLAIM(stop, c);
    if (stop) return;
    STEAL_LOAD(c, ta0, ta1, na0, na1, va0, va1);
    for (;;) {
        STEAL_CLAIM(stop, c);
        if (!stop) STEAL_LOAD(c, tb0, tb1, nb0, nb1, vb0, vb1);
        titem_store(ta0, va0, na0, lane); titem_store(ta1, va1, na1, lane);
        if (stop) break;
        STEAL_CLAIM(stop, c);
        if (!stop) STEAL_LOAD(c, ta0, ta1, na0, na1, va0, va1);
        titem_store(tb0, vb0, nb0, lane); titem_store(tb1, vb1, nb1, lane);
        if (stop) break;
    }
#undef STEAL_CLAIM
#undef STEAL_LOAD
}

__global__ void __launch_bounds__(NWAVES * 64, 2) mega(Args args) {
    extern __shared__ __attribute__((aligned(16))) unsigned char lds_raw[];
    LAS unsigned char* ldsl = (LAS unsigned char*)lds_raw;
    char* ldsg = (char*)lds_raw;
    volatile LAS unsigned* MISC = (volatile LAS unsigned*)(ldsl + MISC_OFF);
    const int wid0 = __builtin_amdgcn_readfirstlane(threadIdx.x >> 6);
    for (int u = threadIdx.x; u < (LDS_BYTES - MISC_OFF) / 4; u += NWAVES * 64) MISC[u] = 0u;
    __syncthreads();
    XcdBarrier bar; bar.bar = WSP(unsigned, WS_CTL) + CW_BAR; bar.x = 0; bar.st = nullptr; bar.wid0 = wid0;
    if (PH_HI() - PH_LO() > 1) bar = xcd_barrier_post(WSP(unsigned, WS_CTL) + CW_BAR, MISC + 8, wid0);
#define SEAM(k) do { if (IN(k) && IN((k) + 1)) { if ((k) <= 15) steal_convert(WSP(unsigned, WS_CTL), (k), (k) == 7 ? Q_A : (k) == 8 ? Q_B : (k) == 15 ? Q_ALL : 0u, MISC, wid0); xcd_barrier(bar); } } while (0)

    if (SITE(0) && IN(0)) REP(0) phase_prologue(args, ldsl, ldsg, wid0);
    SEAM(0);
    if (SITE(1) && IN(1)) { const Geo q = geo(wid0); norm_mod_rows(INP(0), INP(2), TA, INP(6), WSP(float, WS_MODS), 0, 1, WSP(unsigned char, WS_H), q.gw, q.NGW, q.lane); }
    SEAM(1);
    if (SITE(2) && IN(2)) REP(2) phase_inproj<0>(args, ldsl, wid0);
    SEAM(2);
    if (SITE(3) && IN(3)) REP(3) {
        const Geo q = geo(wid0); const bf16_t* PE = WSP(bf16_t, WS_PE); unsigned char* CAT = WSP(unsigned char, WS_CAT);
        { const float* lbl = INP(10); bf16_t* UB = WSP(bf16_t, WS_U); float* DEC = WSP(float, WS_DEC);
          for (int it = q.vcu; it < NBATCH * 8 * NCHK; it += q.G) { const int ci = it % NCHK, h = (it / NCHK) & 7, b = it / (NCHK * 8); hgrn_a_item(ldsg, PE, lbl, UB, DEC, b, h, ci, wid0); } }
        __syncthreads();
        { const float* sink = INP(12);
          for (int it = (q.vcu + q.G / 2) % q.G; it < 544; it += q.G) {
            if (it < 512) win_attn_item2(ldsg, PE, CAT, sink, it >> 7, (it >> 6) & 1, it & 63, false, wid0);
            else { const int r = it - 512; win_attn_item2(ldsg, PE, CAT, sink, r >> 3, (r >> 2) & 1, r & 3, true, wid0); } } }
    }
    SEAM(3);
    if (SITE(4) && IN(4)) REP(4) hgrn_b_phase(WSP(bf16_t, WS_U), WSP(float, WS_DEC), WSP(bf16_t, WS_S), wid0);
    SEAM(4);
    if (SITE(5) && IN(5)) REP(5) { const Geo q = geo(wid0); const bf16_t* PE = WSP(bf16_t, WS_PE); unsigned char* CAT = WSP(unsigned char, WS_CAT); const float* lbl = INP(10); const bf16_t* SB = WSP(bf16_t, WS_S); const float* gh = INP(11);
        for (int it = q.vcu; it < NBATCH * 8 * NCHK; it += q.G) { const int ci = it % NCHK, h = (it / NCHK) & 7, b = it / (NCHK * 8); hgrn_c_item(ldsg, PE, lbl, SB, gh, CAT, b, h, ci, wid0); } }
    SEAM(5);
    if (SITE(8) && IN(6)) REP(6) phase_outproj<0>(args, ldsl, wid0);
    SEAM(6);
    if (SITE(9) && IN(7)) phase_router<0>(args, ldsg, wid0);
    SEAM(7);
    if (SITE(10) && IN(8)) REP(8) phase_moe<0, 0>(args, ldsl, wid0);
    SEAM(8);
    if (SITE(11) && IN(9)) REP(9) phase_moe<0, 1>(args, ldsl, wid0);
    SEAM(9);
    if (SITE(12) && IN(10)) phase_combine<0>(args, ldsl, ldsg, wid0);
    SEAM(10);
    if (SITE(2) && IN(11)) REP(11) phase_inproj<1>(args, ldsl, wid0);
    SEAM(11);
    if (SITE(6) && IN(12)) REP(12) { const Geo q = geo(wid0); post_odd(WSP(bf16_t, WS_PO), INP(16), WSP(float, WS_TAB) + 2048, WSP(unsigned char, WS_KALL), WSP(unsigned char, WS_VALL), ldsg, q.vcu, q.G, q.gw, q.NGW, q.tid, q.lane); }
    SEAM(12);
    if (SITE(7) && IN(13)) REP(13) { const Geo q = geo(wid0); const bf16_t* PO = WSP(bf16_t, WS_PO); const float* gqn = INP(15); const float* tabo = WSP(float, WS_TAB) + 2048; const unsigned char* KALL = WSP(unsigned char, WS_KALL); const unsigned char* VALL = WSP(unsigned char, WS_VALL); unsigned char* CAT = WSP(unsigned char, WS_CAT);
        for (int it = q.vcu; it < 1024; it += q.G) { const int gq = it & 3, qb = (it >> 2) & 15, kvh = (it >> 6) & 3, b = it >> 8, h = kvh * 4 + gq;
            ga::attn_dense_body(PO + ((size_t)(b * SEQ + qb * 256)) * ODD_IN + h * 128, gqn, tabo, qb * 256, KALL + (size_t)((b * 4 + kvh) * 68) * 8192, VALL + (size_t)((b * 4 + kvh) * 68) * 8192,
                                CAT + ((size_t)(b * SEQ + qb * 256)) * D + h * 128, CTXL + SEQ, ldsg, wid0); } }
    SEAM(13);
    if (SITE(8) && IN(14)) phase_outproj<1>(args, ldsl, wid0);
    SEAM(14);
    if (SITE(9) && IN(15)) phase_router<1>(args, ldsg, wid0);
    SEAM(15);
    if (SITE(10) && IN(16)) REP(16) phase_moe<1, 0>(args, ldsl, wid0);
    SEAM(16);
    if (SITE(11) && IN(17)) REP(17) phase_moe<1, 1>(args, ldsl, wid0);
    SEAM(17);
    if (SITE(12) && IN(18)) phase_combine<1>(args, ldsl, ldsg, wid0);
    if (IN(21)) {
        const Geo q = geo(wid0); const bf16_t* buf = WSP(bf16_t, DBG_BUF_OFF); float* outp = OUTP();
        for (size_t i = (size_t)q.bx * 512 + q.tid; i < (size_t)TL * D; i += (size_t)q.G * 512) { const size_t r = i / D, c = i % D; float v = (c < DBG_BUF_NC && r < DBG_NR) ? (DBG_F32 ? ((const float*)buf)[r * DBG_BUF_LD + DBG_BUF_COL0 + c] : bf2f(buf[r * DBG_BUF_LD + DBG_BUF_COL0 + c])) : 0.f; if (DBG_NANCHK == 1) v = (v == v && fabsf(v) < 1e30f) ? 0.f : 1.f; if (DBG_NANCHK == 2) v = (v == v) ? fminf(fmaxf(v, -1e3f), 1e3f) : 1e3f; outp[i] = v; }
    }
    if (IN(19) || IN(20)) {
        const Geo q = geo(wid0); const float* src = INP(0); const float* gf = INP(25); float* outp = OUTP();
        for (int r = q.gw; r < TL; r += q.NGW) { f32x4 v[8]; float ss = 0.f;
#pragma unroll
            for (int j = 0; j < 8; ++j) { v[j] = *(const f32x4*)(src + (size_t)r * D + 4 * q.lane + 256 * j); ss += (v[j][0] * v[j][0] + v[j][1] * v[j][1]) + (v[j][2] * v[j][2] + v[j][3] * v[j][3]); }
            const float rstd = rsqrtf(wave_sum(ss) * (1.0f / D) + EPS);
#pragma unroll
            for (int j = 0; j < 8; ++j) *(f32x4*)(outp + (size_t)r * D + 4 * q.lane + 256 * j) = v[j] * rstd * *(const f32x4*)(gf + 4 * q.lane + 256 * j); }
    }
#undef SEAM
}

extern "C" void kernel_launch(void* const* d_in, const int* in_sizes, int n_in, void* d_out, int out_size, void* d_ws, size_t ws_size, hipStream_t stream) {
    static int grid = 0;
    if (grid == 0) {
        if (n_in != 26 || in_sizes[0] != TL * D || out_size != TL * D || ws_size < WS_END) { fprintf(stderr, "kernel_launch: unexpected shapes (n_in %d, in0 %d, out %d, ws %zu < %zu)\n", n_in, n_in > 0 ? in_sizes[0] : -1, out_size, ws_size, (size_t)WS_END); grid = -1; return; }
        int dev = 0, cus = 0, per_cu = 0;
        if (hipGetDevice(&dev) != hipSuccess || hipDeviceGetAttribute(&cus, hipDeviceAttributeMultiprocessorCount, dev) != hipSuccess) { grid = -1; return; }
        if (hipFuncSetAttribute((const void*)mega, hipFuncAttributeMaxDynamicSharedMemorySize, LDS_BYTES) != hipSuccess) { fprintf(stderr, "kernel_launch: hipFuncSetAttribute failed\n"); grid = -1; return; }
        if (hipOccupancyMaxActiveBlocksPerMultiprocessor(&per_cu, (const void*)mega, NWAVES * 64, LDS_BYTES) != hipSuccess || per_cu < 1) fprintf(stderr, "kernel_launch: occupancy query reports %d\n", per_cu);
        (void)hipGetLastError();
        grid = cus;
    }
    if (grid < 0) return;
    if (hipMemsetAsync((char*)d_ws + WS_CTL, 0, CTL_ZERO_BYTES, stream) != hipSuccess) return;
    Args a{};
    for (int i = 0; i < 26; ++i) a.in[i] = (const float*)d_in[i];
    a.out = (float*)d_out; a.ws = (unsigned char*)d_ws;
#if N_LAUNCH_MODE == 1
    a.ph_lo = 0; a.ph_hi = NPHASE;
    hipLaunchKernelGGL(mega, dim3(grid), dim3(NWAVES * 64), LDS_BYTES, stream, a);
#else
    for (int p = 0; p < DBG_NPH; ++p) { a.ph_lo = p; a.ph_hi = p + 1; hipLaunchKernelGGL(mega, dim3(grid), dim3(NWAVES * 64), LDS_BYTES, stream, a); }
    if (DBG_FIN) { a.ph_lo = DBG_FIN; a.ph_hi = DBG_FIN + 1; hipLaunchKernelGGL(mega, dim3(grid), dim3(NWAVES * 64), LDS_BYTES, stream, a); }
#endif
    const hipError_t le = hipPeekAtLastError();
    if (le != hipSuccess) fprintf(stderr, "kernel_launch: launch failed: %s\n", hipGetErrorName(le));
}
```

```cpp
#include <hip/hip_runtime.h>
#include <cstdio>
#include <cstdint>
#include <cstddef>

#ifndef N_LAUNCH_MODE
#define N_LAUNCH_MODE 1
#endif
#define REPEAT_MASK 0u
#define REP(k) for (int rep_ = 0; rep_ < 1 + (int)((REPEAT_MASK >> (k)) & 1u); ++rep_)
#define DBG_NPH 19
#define DBG_BUF_OFF WS_U
#define DBG_BUF_LD 2048
#define DBG_BUF_COL0 0
#define DBG_BUF_NC 2048
#define DBG_NANCHK 2
#define DBG_F32 0
#define DBG_NR 16384
#define DBG_FIN 0

#define LAS __attribute__((address_space(3)))
#define GAS __attribute__((address_space(1)))
typedef unsigned short bf16_t;
typedef short bf16x8 __attribute__((ext_vector_type(8)));
typedef short s16x4 __attribute__((ext_vector_type(4)));
typedef float f32x4 __attribute__((ext_vector_type(4)));
typedef float f32x2 __attribute__((ext_vector_type(2)));
typedef unsigned u32x4 __attribute__((ext_vector_type(4)));
typedef unsigned u32x2 __attribute__((ext_vector_type(2)));

constexpr int D = 2048, NBATCH = 4, SEQ = 4096, CTXL = 256;
constexpr int TL = NBATCH * SEQ, TC = NBATCH * CTXL, TA = TL + TC;
constexpr int EVEN_IN = 6400, ODD_IN = 3072;
constexpr int NE = 64, DEXP = 512;
constexpr int NCHK = 68;
constexpr float EPS = 1e-6f;
constexpr int MODW = 6 * D;

constexpr size_t MiB = 1u << 20;
constexpr size_t WS_CTL = 0, CTL_ZERO_BYTES = 1 * MiB;
constexpr size_t WS_MODS = 1 * MiB;
constexpr size_t WS_TAB = 2 * MiB;
constexpr size_t WS_WR = 3 * MiB;
constexpr size_t WS_WINE = 4 * MiB;
constexpr size_t WS_WOUTE = 29 * MiB;
constexpr size_t WS_WINO = 37 * MiB;
constexpr size_t WS_WOUTO = 49 * MiB;
constexpr size_t WS_WGU = 57 * MiB;
constexpr size_t WS_WDN = 577 * MiB;
constexpr size_t WS_X1 = 837 * MiB;
constexpr size_t WS_H = 973 * MiB;
constexpr size_t WS_CAT = 1041 * MiB;
constexpr size_t WS_LIST = 1109 * MiB;
constexpr size_t WS_WTS = 1113 * MiB + 512 * 1024;
constexpr size_t WS_SLOTI = WS_WTS + (size_t)8 * TA * 4;
constexpr size_t WS_R = 1115 * MiB;
constexpr size_t WS_PE = WS_R, WS_U = WS_R + 213 * MiB, WS_S = WS_R + 349 * MiB, WS_DEC = WS_R + 485 * MiB;
constexpr size_t WS_PO = WS_R, WS_QN = WS_R + 102 * MiB, WS_KALL = WS_R + 166 * MiB, WS_VALL = WS_R + 183 * MiB;
constexpr int MAXTILES = 675;
constexpr size_t WS_HID = WS_R, WS_Y = WS_R + 85 * MiB, WS_H8 = WS_R + 760 * MiB;
constexpr size_t WS_END = WS_R + 794 * MiB;
static_assert((size_t)TA * EVEN_IN * 2 <= 213 * MiB && (size_t)NBATCH * 8 * 2 * NCHK * 128 * 128 * 2 <= 136 * MiB, "even map");
static_assert((size_t)MAXTILES * 256 * 512 <= 85 * MiB && (size_t)MAXTILES * 256 * 2048 * 2 <= 675 * MiB && (size_t)TA * 2048 <= 34 * MiB && (8 * TA + 64 * 255) / 256 + 68 <= MAXTILES, "moe map");
static_assert((size_t)TA * ODD_IN * 2 <= 102 * MiB && (size_t)TL * 2048 * 2 <= 64 * MiB && (size_t)NBATCH * 4352 * 512 * 2 <= 17 * MiB, "odd map");
static_assert(WS_SLOTI + (size_t)8 * TA * 4 <= WS_R && WS_LIST + (size_t)64 * TA * 4 <= WS_WTS, "list / wts / slot info");
constexpr int CW_BAR = 4096;
constexpr int CW_CNT = 16384;
constexpr int CW_Q = 32768;
constexpr int CW_ARR = 32768 + 64;

constexpr int LDS_BYTES = 155648;
constexpr int MISC_OFF = 153600;
constexpr int NWAVES = 8;

typedef __bf16 bf16v2 __attribute__((ext_vector_type(2)));
__device__ __forceinline__ unsigned cvt_pk(float lo, float hi) { f32x2 v = {lo, hi}; bf16v2 b = __builtin_convertvector(v, bf16v2); return __builtin_bit_cast(unsigned, b); }
__device__ __forceinline__ float bflo(unsigned u) { return __uint_as_float(u << 16); }
__device__ __forceinline__ float bfhi(unsigned u) { return __uint_as_float(u & 0xffff0000u); }
__device__ __forceinline__ float bf2f(bf16_t u) { return __uint_as_float(((unsigned)u) << 16); }
__device__ __forceinline__ bf16_t f2bf(float f) { return (bf16_t)(cvt_pk(f, 0.f) & 0xffffu); }
__device__ __forceinline__ unsigned char f2fp8(float f) { return (unsigned char)(__builtin_amdgcn_cvt_pk_fp8_f32(f, 0.f, 0, false) & 0xff); }
__device__ __forceinline__ float wave_sum(float v) {
#pragma unroll
    for (int o = 1; o < 64; o <<= 1) v += __shfl_xor(v, o);
    return v;
}
__device__ __forceinline__ float sigmoidf_(float x) { return __builtin_amdgcn_rcpf(1.0f + __builtin_amdgcn_exp2f(-1.4426950408889634f * x)); }
__device__ __forceinline__ float siluf_(float x) { return x * __builtin_amdgcn_rcpf(1.0f + __builtin_amdgcn_exp2f(-1.4426950408889634f * x)); }
__device__ __forceinline__ int opaque_tid(int wid0) { int t = wid0 * 64 + (int)__builtin_amdgcn_mbcnt_hi(~0u, __builtin_amdgcn_mbcnt_lo(~0u, 0u)); asm volatile("" : "+v"(t)); return t; }
#define LDS_WAIT() asm volatile("s_waitcnt lgkmcnt(0)" ::: "memory")
#define VM_WAIT() asm volatile("s_waitcnt vmcnt(0)" ::: "memory")

#define XB_TMO      128
#define XB_XCNT(j)  (256  + 64 * (j))
#define XB_XSUB(j)  (1280 + 64 * (j))
#define XB_XGEN(j)  (2304 + 64 * (j))
#define XB_TOP      3328
#define XB_TOPGEN   3392
#define XCD_BAR_WORDS 3456
#define XB_SPIN_CAP (1u << 18)
__device__ __forceinline__ unsigned xb_ld(unsigned* p)              { return __hip_atomic_load(p, __ATOMIC_RELAXED, __HIP_MEMORY_SCOPE_AGENT); }
__device__ __forceinline__ unsigned xb_add(unsigned* p, unsigned v) { return __hip_atomic_fetch_add(p, v, __ATOMIC_RELAXED, __HIP_MEMORY_SCOPE_AGENT); }
__device__ __forceinline__ unsigned xb_xcc_id() { return (unsigned)__builtin_amdgcn_s_getreg((3 << 11) | 20) & 0xFu; }
#define XB_SPIN(cond, bar) do { unsigned _sp = 0; while (cond) { __builtin_amdgcn_s_sleep(1); \
    if ((++_sp & 255u) == 0u) { if (xb_ld(&(bar)[XB_TMO])) break; if (_sp > XB_SPIN_CAP) { atomicAdd(&(bar)[XB_TMO], 1u); break; } } } } while (0)
struct XcdBarrier { unsigned* bar; unsigned x; volatile LAS unsigned* st; int wid0; };
__device__ __forceinline__ bool xb_leader(int wid0) { return wid0 == 0 && __builtin_amdgcn_mbcnt_hi(~0u, __builtin_amdgcn_mbcnt_lo(~0u, 0u)) == 0u; }
__device__ __forceinline__ XcdBarrier xcd_barrier_post(unsigned* bar, volatile LAS unsigned* st, int wid0) {
    XcdBarrier b; b.bar = bar; b.x = xb_xcc_id(); b.st = st; b.wid0 = wid0;
    if (xb_leader(wid0)) (void)xb_add(&bar[XB_XCNT(b.x)], 1u);
    return b;
}
__device__ __forceinline__ void xcd_barrier_complete(unsigned* bar, unsigned x, unsigned& nloc, unsigned& nx) {
    const unsigned G = gridDim.x * gridDim.y * gridDim.z;
    unsigned sum, cnt, mine, sp = 0u;
    for (;;) {
        sum = 0u; cnt = 0u; mine = 0u;
#pragma unroll
        for (unsigned j = 0; j < 16; ++j) { const unsigned c = xb_ld(&bar[XB_XCNT(j)]); sum += c; cnt += (c > 0u) ? 1u : 0u; mine = (j == x) ? c : mine; }
        if (sum == G) break;
        __builtin_amdgcn_s_sleep(1);
        if ((++sp & 255u) == 0u) { if (xb_ld(&bar[XB_TMO])) break; if (sp > XB_SPIN_CAP) { atomicAdd(&bar[XB_TMO], 1u); break; } }
    }
    nloc = mine > 0u ? mine : 1u; nx = cnt > 0u ? cnt : 1u;
}
__device__ __forceinline__ void xcd_barrier(const XcdBarrier& b) {
    asm volatile("s_waitcnt vmcnt(0)" ::: "memory");
    __syncthreads();
    if (xb_leader(b.wid0)) {
        unsigned* bar = b.bar;
        __builtin_amdgcn_s_waitcnt(0);
        unsigned nloc = b.st[0], nx = b.st[1];
        if (nloc == 0u) { xcd_barrier_complete(bar, b.x, nloc, nx); b.st[0] = nloc; b.st[1] = nx; }
        const unsigned old = xb_add(&bar[XB_XSUB(b.x)], 1u);
        const unsigned gen = old / nloc;
        if (old + 1u == (gen + 1u) * nloc) {
            __builtin_amdgcn_fence(__ATOMIC_RELEASE, "agent");
            asm volatile("s_waitcnt vmcnt(0)" ::: "memory");
            const unsigned og = xb_add(&bar[XB_TOP], 1u);
            const unsigned tg = og / nx;
            if (og + 1u == (tg + 1u) * nx) xb_add(&bar[XB_TOPGEN], 1u);
            else XB_SPIN(xb_ld(&bar[XB_TOPGEN]) == tg, bar);
            __builtin_amdgcn_fence(__ATOMIC_ACQUIRE, "agent");
            xb_add(&bar[XB_XGEN(b.x)], 1u);
            asm volatile("s_waitcnt vmcnt(0)" ::: "memory");
        } else {
            XB_SPIN(xb_ld(&bar[XB_XGEN(b.x)]) == gen, bar);
            __builtin_amdgcn_fence(__ATOMIC_ACQUIRE, "agent");
            asm volatile("s_waitcnt vmcnt(0)" ::: "memory");
        }
    }
    __syncthreads();
}

namespace pg8 {
constexpr int BM = 256, BK = 64, HALF = 128, HTB = HALF * BK * 2, STAGE_BYTES = 8 * HTB, NXCD = 8, WGM = 8;
__host__ __device__ __forceinline__ int lds_byte(int r, int c) { const int st = (r >> 4) * 2 + (c >> 5), rr = r & 15, cc = c & 31, ob = rr * 64 + cc * 2; return st * 1024 + (ob ^ (((ob >> 9) & 1) << 5)); }
__host__ __device__ __forceinline__ void stage_rc(int b, int& R, int& C) { const int st = b / 1024, sb = b % 1024, swz = sb ^ (((sb >> 9) & 1) << 5); R = (st >> 1) * 16 + swz / 64; C = (st & 1) * 32 + (swz % 64) / 2; }

__host__ __device__ __forceinline__ int perm32(int rho) { const int n = rho >> 4, i = rho & 15; return 8 * (i >> 2) + 4 * n + (i & 3); }
struct Unit { int pm, pn, e, cnt, tb; };

struct DenseSched {
    static constexpr bool DENSE = true;
    int nM, nN, nwg, G, c; unsigned rowbytes; const char* Bt; size_t tstepB;
    __device__ void init(int M, int N, int K, int G_, int c_, const void* Bt_) { nM = M / BM; nN = N / BM; nwg = nM * nN; G = G_; c = c_; rowbytes = (unsigned)K * 2u; Bt = (const char*)Bt_; tstepB = (size_t)256 * K * 2; }
    __device__ __forceinline__ bool next(int i, Unit& u) const {
        const long L = (long)i * G + c; if (L >= nwg) return false;
        int wgid = (int)L; { const int q = nwg / NXCD, r = nwg % NXCD, xcd = wgid % NXCD, off = wgid / NXCD; wgid = (xcd < r ? xcd * (q + 1) : r * (q + 1) + (xcd - r) * q) + off; }
        const int nig = WGM * nN, gid = wgid / nig, fm = gid * WGM, gsz = (nM - fm) < WGM ? (nM - fm) : WGM;
        u.pm = fm + ((wgid % nig) % gsz); u.pn = (wgid % nig) / gsz; u.e = 0; u.cnt = 1 << 30; u.tb = 0; return true;
    }
    __device__ __forceinline__ unsigned arow(const Unit& u, int r) const { return (unsigned)(u.pm * BM + r) * rowbytes; }
    __device__ __forceinline__ const char* bbase(const Unit& u) const { return Bt + (size_t)u.pn * tstepB; }
};
struct MoeSched {
    static constexpr bool DENSE = false; unsigned rowbytes;
    const LAS int* ustart; const LAS int* ecnt; const LAS int* tstart; int total, G, c, NT, mode; const int* list; const char* Bt; size_t estepB, tstepB;
    __device__ __forceinline__ bool next(int i, Unit& u) const {
        const long Lx = (long)i * G + c; if (Lx >= total) return false; const int L = (int)Lx;
        int lo = 0, hi = 65; while (hi - lo > 1) { const int mid = (lo + hi) >> 1; if (ustart[mid] <= L) lo = mid; else hi = mid; }
        const int loc = L - ustart[lo]; u.e = lo; u.pm = loc / NT; u.pn = loc % NT; u.cnt = ecnt[lo]; u.tb = tstart[lo] + u.pm; return true;
    }
    __device__ __forceinline__ unsigned arow(const Unit& u, int r) const {
        if (mode == 1) return (unsigned)(u.tb * BM + r) * 512u;
        int p = u.pm * BM + r; if (p >= u.cnt) p = 0;
        const int tok = (u.e == 64) ? p : list[(size_t)u.e * TA + p];
        return (unsigned)tok * 2048u;
    }
    __device__ __forceinline__ const char* bbase(const Unit& u) const { return Bt + (size_t)u.e * estepB + (size_t)u.pn * tstepB; }
};

typedef int v8i_t __attribute__((ext_vector_type(8)));
typedef int v4i_t __attribute__((ext_vector_type(4)));
template <class Epi, class Sched, bool ALIGN_EPI, int WSCALE = 0, bool SP2 = false>
__device__ __forceinline__ void gemm_phase(LAS unsigned char* lds, const char* Abase, const int K, const Sched& S, const Epi& E, const int wid0) {
    const int tid = opaque_tid(wid0), wid = __builtin_amdgcn_readfirstlane(tid >> 6), lane = tid & 63, wr = wid >> 2, wc = wid & 3, fr = lane & 15, fq = lane >> 4;
    const int nt = K / BK;
    unsigned voffB[2];
#pragma unroll
    for (int i = 0; i < 2; ++i) { int R, C; stage_rc(tid * 16 + i * 8192, R, C); const int Rb = Epi::PERM ? ((R & ~31) + perm32(R & 31)) : R; voffB[i] = (unsigned)(Rb * K + C) * 2u; }
#define PG8_AOFF(dst0, dst1, U) do { _Pragma("unroll") for (int _i = 0; _i < 2; ++_i) { int _R, _C; stage_rc(tid * 16 + _i * 8192, _R, _C); \
        dst0[_i] = S.arow(U, _R) + (unsigned)_C * 2u; if constexpr (!Sched::DENSE) dst1[_i] = S.arow(U, _R + HALF) + (unsigned)_C * 2u; } } while (0)
    const size_t hstepA = Sched::DENSE ? (size_t)HALF * S.rowbytes : (size_t)0;
#define PG8_CV1 (Sched::DENSE ? cv0 : cv1)
    const size_t hstep = (size_t)HALF * K * 2;
    const unsigned ldsw = (unsigned)wid * 1024u;
    const int aoff = lds_byte(wr * 64 + fr, fq * 8), boff = lds_byte(wc * 32 + fr, fq * 8);
#define PG8_SA(b, h) (((b) * 2 + (h)) * HTB)
#define PG8_SB(b, h) ((4 + (b) * 2 + (h)) * HTB)
#define PG8_STAGE(bufoff, gbase, voff) do { _Pragma("unroll") for (int _i = 0; _i < 2; ++_i) \
        __builtin_amdgcn_global_load_lds((const unsigned*)((const char*)(gbase) + (voff)[_i]), (LAS unsigned*)(lds + (bufoff) + ldsw + _i * 8192), 16, 0, 0); } while (0)
#define PG8_LDA(dst, b, h) do { _Pragma("unroll") for (int m = 0; m < 4; ++m) { const v4i_t lo_ = *(const LAS v4i_t*)(lds + PG8_SA(b, h) + aoff + m * 2048), hi_ = *(const LAS v4i_t*)(lds + PG8_SA(b, h) + aoff + m * 2048 + 1024); \
        dst[m] = __builtin_shufflevector(lo_, hi_, 0, 1, 2, 3, 4, 5, 6, 7); } } while (0)
#define PG8_LDB(dst, b, h) do { _Pragma("unroll") for (int n = 0; n < 2; ++n) { const v4i_t lo_ = *(const LAS v4i_t*)(lds + PG8_SB(b, h) + boff + n * 2048), hi_ = *(const LAS v4i_t*)(lds + PG8_SB(b, h) + boff + n * 2048 + 1024); \
        dst[n] = __builtin_shufflevector(lo_, hi_, 0, 1, 2, 3, 4, 5, 6, 7); } } while (0)
#define PG8_LO(x) __builtin_bit_cast(bf16x8, __builtin_shufflevector(x, x, 0, 1, 2, 3))
#define PG8_HI(x) __builtin_bit_cast(bf16x8, __builtin_shufflevector(x, x, 4, 5, 6, 7))
#define PG8_MMA(ai, bj, At, Bt) do { __builtin_amdgcn_s_setprio(1); _Pragma("unroll") for (int m = 0; m < 4; ++m) _Pragma("unroll") for (int n = 0; n < 2; ++n) { \
        if constexpr (WSCALE != 0) asm volatile("v_mfma_scale_f32_16x16x128_f8f6f4 %0, %1, %2, %0, %3, %4 op_sel_hi:[0,0,0]" : "+v"(acc[ai][bj][m][n]) : "v"(Bt[n]), "v"(At[m]), "v"(scw), "v"(sca)); \
        else { acc[ai][bj][m][n] = __builtin_amdgcn_mfma_f32_16x16x32_bf16(PG8_LO(Bt[n]), PG8_LO(At[m]), acc[ai][bj][m][n], 0, 0, 0); \
               acc[ai][bj][m][n] = __builtin_amdgcn_mfma_f32_16x16x32_bf16(PG8_HI(Bt[n]), PG8_HI(At[m]), acc[ai][bj][m][n], 0, 0, 0); } } \
        __builtin_amdgcn_s_setprio(0); } while (0)
#define PG8_WAIT_V(n) asm volatile("s_waitcnt vmcnt(" #n ")" ::: "memory")
#define PG8_WAIT_L(n) asm volatile("s_waitcnt lgkmcnt(" #n ")" ::: "memory")
#define PG8_BAR __builtin_amdgcn_s_barrier()
#define PG8_SCHED __builtin_amdgcn_sched_barrier(0)
    Unit cur, nxt; int ui = 0;
    if (!S.next(0, cur)) return;
    f32x4 acc[2][2][4][2];
#pragma unroll
    for (int a = 0; a < 2; ++a)
#pragma unroll
        for (int b = 0; b < 2; ++b)
#pragma unroll
            for (int m = 0; m < 4; ++m)
#pragma unroll
                for (int n = 0; n < 2; ++n) acc[a][b][m][n] = (f32x4){0.f, 0.f, 0.f, 0.f};
    v8i_t At[4], B0[2], B1[2];
    int scw = WSCALE, sca = 127; asm volatile("" : "+v"(scw), "+v"(sca));
    unsigned cv0[2], cv1[2];
    PG8_AOFF(cv0, cv1, cur);
    const char* cB = S.bbase(cur);
    if constexpr (SP2) {
        PG8_STAGE(PG8_SB(0, 0), cB, voffB); PG8_STAGE(PG8_SB(0, 1), cB + hstep, voffB); PG8_STAGE(PG8_SA(0, 0), Abase, cv0); PG8_STAGE(PG8_SA(0, 1), Abase + hstepA, PG8_CV1);
        if (wr == 1) PG8_BAR;
        PG8_WAIT_V(2); PG8_BAR;
    } else {
        PG8_STAGE(PG8_SB(0, 0), cB, voffB); PG8_STAGE(PG8_SA(0, 0), Abase, cv0); PG8_STAGE(PG8_SB(0, 1), cB + hstep, voffB); PG8_STAGE(PG8_SA(0, 1), Abase + hstepA, PG8_CV1);
        if (wr == 1) PG8_BAR;
        PG8_WAIT_V(4); PG8_BAR;
    }
    PG8_STAGE(PG8_SB(1, 0), cB + 128, voffB); PG8_STAGE(PG8_SA(1, 0), Abase + 128, cv0); PG8_STAGE(PG8_SB(1, 1), cB + hstep + 128, voffB);
    PG8_WAIT_V(6); PG8_BAR;
#define PG8_TRIP(LASTF) do { \
        const char* a1 = Abase + (size_t)(t + 1) * 128; \
        const char* a2 = Abase + ((LASTF) ? (size_t)0 : (size_t)(t + 2) * 128); const char* b2 = (LASTF) ? nB : cB + (size_t)(t + 2) * 128; \
        const char* a3 = a2 + 128; const char* b3 = b2 + 128; \
        PG8_LDB(B0, 0, 0); PG8_SCHED; PG8_LDA(At, 0, 0); PG8_STAGE(PG8_SA(1, 1), a1 + hstepA, PG8_CV1); \
        PG8_WAIT_L(8); PG8_BAR; PG8_WAIT_L(0); PG8_MMA(0, 0, At, B0); PG8_BAR; PG8_SCHED; \
        if (LASTF) { if (has_next) PG8_AOFF(cv0, cv1, nxt); } \
        PG8_LDB(B1, 0, 1); PG8_STAGE(PG8_SB(0, 0), b2, voffB); \
        PG8_BAR; PG8_WAIT_L(0); PG8_MMA(0, 1, At, B1); PG8_BAR; \
        PG8_LDA(At, 0, 1); PG8_STAGE(PG8_SA(0, 0), a2, cv0); \
        PG8_BAR; PG8_WAIT_L(0); PG8_MMA(1, 0, At, B0); PG8_BAR; PG8_SCHED; \
        PG8_STAGE(PG8_SB(0, 1), b2 + hstep, voffB); \
        PG8_WAIT_V(6); PG8_BAR; PG8_MMA(1, 1, At, B1); PG8_BAR; \
        PG8_LDB(B0, 1, 0); PG8_SCHED; PG8_LDA(At, 1, 0); PG8_STAGE(PG8_SA(0, 1), a2 + hstepA, PG8_CV1); \
        PG8_WAIT_L(8); PG8_BAR; PG8_WAIT_L(0); PG8_MMA(0, 0, At, B0); PG8_BAR; PG8_SCHED; \
        PG8_LDB(B1, 1, 1); PG8_STAGE(PG8_SB(1, 0), b3, voffB); \
        PG8_BAR; PG8_WAIT_L(0); PG8_MMA(0, 1, At, B1); PG8_BAR; \
        PG8_LDA(At, 1, 1); PG8_STAGE(PG8_SA(1, 0), a3, cv0); \
        PG8_BAR; PG8_WAIT_L(0); PG8_MMA(1, 0, At, B0); PG8_BAR; PG8_SCHED; \
        PG8_STAGE(PG8_SB(1, 1), b3 + hstep, voffB); \
        PG8_WAIT_V(6); PG8_BAR; PG8_MMA(1, 1, At, B1); PG8_BAR; \
    } while (0)
#define PG8_TRIP2(LASTF) do { \
        const char* a1 = Abase + (size_t)(t + 1) * 128; \
        const char* a2 = Abase + ((LASTF) ? (size_t)0 : (size_t)(t + 2) * 128); const char* b2 = (LASTF) ? nB : cB + (size_t)(t + 2) * 128; \
        const char* a3 = a2 + 128; const char* b3 = b2 + 128; \
        PG8_LDB(B0, 0, 0); PG8_LDB(B1, 0, 1); PG8_SCHED; PG8_LDA(At, 0, 0); PG8_STAGE(PG8_SA(1, 1), a1 + hstepA, PG8_CV1); \
        PG8_WAIT_V(8); PG8_WAIT_L(0); PG8_BAR; PG8_MMA(0, 0, At, B0); PG8_MMA(0, 1, At, B1); PG8_BAR; PG8_SCHED; \
        if (LASTF) { if (has_next) PG8_AOFF(cv0, cv1, nxt); } \
        PG8_LDA(At, 0, 1); PG8_STAGE(PG8_SB(0, 0), b2, voffB); PG8_STAGE(PG8_SB(0, 1), b2 + hstep, voffB); PG8_STAGE(PG8_SA(0, 0), a2, cv0); \
        PG8_WAIT_V(8); PG8_WAIT_L(0); PG8_BAR; PG8_MMA(1, 0, At, B0); PG8_MMA(1, 1, At, B1); PG8_BAR; PG8_SCHED; \
        PG8_LDB(B0, 1, 0); PG8_LDB(B1, 1, 1); PG8_SCHED; PG8_LDA(At, 1, 0); PG8_STAGE(PG8_SA(0, 1), a2 + hstepA, PG8_CV1); \
        PG8_WAIT_V(8); PG8_WAIT_L(0); PG8_BAR; PG8_MMA(0, 0, At, B0); PG8_MMA(0, 1, At, B1); PG8_BAR; PG8_SCHED; \
        PG8_LDA(At, 1, 1); PG8_STAGE(PG8_SB(1, 0), b3, voffB); PG8_STAGE(PG8_SB(1, 1), b3 + hstep, voffB); PG8_STAGE(PG8_SA(1, 0), a3, cv0); \
        PG8_WAIT_V(8); PG8_WAIT_L(0); PG8_BAR; PG8_MMA(1, 0, At, B0); PG8_MMA(1, 1, At, B1); PG8_BAR; PG8_SCHED; \
    } while (0)
    for (;;) {
        const bool has_next = S.next(ui + 1, nxt);
        const char* nB = has_next ? S.bbase(nxt) : cB;
        int t = 0;
#pragma nounroll
        for (; t < nt - 2; t += 2) { if constexpr (Epi::ASPLIT >= 0) { sca = t >= Epi::ASPLIT ? 127 - 4 : 127; asm volatile("" : "+v"(sca)); } if constexpr (SP2) PG8_TRIP2(false); else PG8_TRIP(false); }
        if constexpr (Epi::ASPLIT >= 0) { sca = t >= Epi::ASPLIT ? 127 - 4 : 127; asm volatile("" : "+v"(sca)); }
        if constexpr (SP2) PG8_TRIP2(true); else PG8_TRIP(true);
        if constexpr (ALIGN_EPI) { if (wr == 0) PG8_BAR; }
        if constexpr (WSCALE != 0) asm volatile("s_nop 15\n\ts_nop 15\n\ts_nop 15" ::: "memory");
        E(acc, cur, wr, wc, fr, fq);
        if (!has_next) break;
#pragma unroll
        for (int a = 0; a < 2; ++a)
#pragma unroll
            for (int b = 0; b < 2; ++b)
#pragma unroll
                for (int m = 0; m < 4; ++m)
#pragma unroll
                    for (int n = 0; n < 2; ++n) acc[a][b][m][n] = (f32x4){0.f, 0.f, 0.f, 0.f};
        cur = nxt; cB = nB; ++ui;
        if constexpr (ALIGN_EPI) { if (wr == 1) PG8_BAR; }
    }
    PG8_WAIT_V(0);
    if constexpr (!ALIGN_EPI) { if (wr == 0) PG8_BAR; }
    PG8_BAR;
#undef PG8_TRIP
#undef PG8_TRIP2
#undef PG8_AOFF
#undef PG8_CV1
#undef PG8_SA
#undef PG8_SB
#undef PG8_STAGE
#undef PG8_LDA
#undef PG8_LDB
#undef PG8_MMA
#undef PG8_LO
#undef PG8_HI
#undef PG8_WAIT_V
#undef PG8_WAIT_L
#undef PG8_BAR
#undef PG8_SCHED
}

struct EpiProj {
    static constexpr bool PERM = false; static constexpr int ASPLIT = -1;
    bf16_t* O; int ld; int rope_lo, rope_hi, rope_half;
    const float* tab;
    __device__ __forceinline__ void operator()(const f32x4 (&acc)[2][2][4][2], const Unit& u, int wr, int wc, int fr, int fq) const {
        const int row0 = u.pm * BM + wr * 64 + fr, col0 = u.pn * BM + wc * 32 + 4 * fq;
        const bool lat = (u.pm * BM) < TL;
        const bool rfull = lat && u.pn >= rope_lo && u.pn < rope_hi, rhalf = lat && u.pn == rope_half;
#pragma unroll
        for (int ai = 0; ai < 2; ++ai)
#pragma unroll
            for (int m = 0; m < 4; ++m) {
                const int r = row0 + ai * HALF + m * 16;
                f32x4 cs = (f32x4){1.f, 1.f, 1.f, 1.f}, sn = (f32x4){0.f, 0.f, 0.f, 0.f};
                if (rfull || rhalf) { const int t = r & (SEQ - 1); const int pos = (wc & 1) ? (t & 63) : (t >> 6);
                    cs = *(const f32x4*)(tab + pos * 16 + 4 * fq); sn = *(const f32x4*)(tab + 1024 + pos * 16 + 4 * fq); }
                bf16_t* rowp = O + (size_t)r * ld + col0;
#pragma unroll
                for (int bj = 0; bj < 2; ++bj) {
                    f32x4 x1 = acc[ai][bj][m][0], x2 = acc[ai][bj][m][1];
                    if (rfull || (rhalf && bj == 0)) { const f32x4 y1 = x1 * cs - x2 * sn, y2 = x2 * cs + x1 * sn; x1 = y1; x2 = y2; }
                    u32x2 w0, w1; w0.x = cvt_pk(x1[0], x1[1]); w0.y = cvt_pk(x1[2], x1[3]); w1.x = cvt_pk(x2[0], x2[1]); w1.y = cvt_pk(x2[2], x2[3]);
                    *(u32x2*)(rowp + bj * HALF) = w0; *(u32x2*)(rowp + bj * HALF + 16) = w1;
                }
            }
    }
};
template <bool BASE_BF16> struct EpiOutRes {
    static constexpr bool PERM = false; static constexpr int ASPLIT = BASE_BF16 ? 0 : 8;
    const float* base_lat; const float* base_ctx; bf16_t* out; const float* gate;
    __device__ __forceinline__ void operator()(const f32x4 (&acc)[2][2][4][2], const Unit& u, int wr, int wc, int fr, int fq) const {
        const int row0 = u.pm * BM + wr * 64 + fr, col0 = u.pn * BM + wc * 32 + 4 * fq;
        const bool lat = (u.pm * BM) < TL; const int rt = lat ? (u.pm >> 4) : 4;
        const float* bs = lat ? base_lat : base_ctx - (size_t)TL * D;
        f32x4 gv[2][2];
#pragma unroll
        for (int bj = 0; bj < 2; ++bj)
#pragma unroll
            for (int n = 0; n < 2; ++n) gv[bj][n] = *(const f32x4*)(gate + (size_t)rt * MODW + col0 + bj * HALF + n * 16);
#pragma unroll
        for (int ai = 0; ai < 2; ++ai)
#pragma unroll
            for (int m = 0; m < 4; ++m) { const size_t off = (size_t)(row0 + ai * HALF + m * 16) * D + col0;
#pragma unroll
                for (int bj = 0; bj < 2; ++bj)
#pragma unroll
                    for (int n = 0; n < 2; ++n) { f32x4 b;
                        if constexpr (BASE_BF16) { const u32x2 w = *(const u32x2*)(out + off + bj * HALF + n * 16); b = (f32x4){bflo(w.x), bfhi(w.x), bflo(w.y), bfhi(w.y)}; }
                        else b = *(const f32x4*)(bs + off + bj * HALF + n * 16);
                        const f32x4 y = b + gv[bj][n] * acc[ai][bj][m][n]; u32x2 o; o.x = cvt_pk(y[0], y[1]); o.y = cvt_pk(y[2], y[3]); *(u32x2*)(out + off + bj * HALF + n * 16) = o; }
                asm volatile("" ::: "memory"); }
    }
};
struct EpiGateUp {
    static constexpr bool PERM = true; static constexpr int ASPLIT = -1;
    unsigned char* hid;
    __device__ __forceinline__ void operator()(const f32x4 (&acc)[2][2][4][2], const Unit& u, int wr, int wc, int fr, int fq) const {
        const int colh = u.pn * 128 + wc * 32 + 8 * fq;
#pragma unroll
        for (int ai = 0; ai < 2; ++ai)
#pragma unroll
            for (int m = 0; m < 4; ++m) {
                unsigned char* rowp = hid + (size_t)(u.tb * BM + ai * HALF + wr * 64 + m * 16 + fr) * DEXP + colh;
                u32x2 o;
#pragma unroll
                for (int n = 0; n < 2; ++n) { const f32x4 g = acc[ai][0][m][n], up = acc[ai][1][m][n]; f32x4 h;
#pragma unroll
                    for (int j = 0; j < 4; ++j) h[j] = g[j] * __builtin_amdgcn_rcpf(1.0f + __expf(-g[j])) * up[j];
                    int w = 0; w = __builtin_amdgcn_cvt_pk_fp8_f32(h[0], h[1], w, false); w = __builtin_amdgcn_cvt_pk_fp8_f32(h[2], h[3], w, true);
                    if (n == 0) o.x = (unsigned)w; else o.y = (unsigned)w; }
                *(u32x2*)rowp = o;
            }
    }
};
struct EpiDown {
    static constexpr bool PERM = true; static constexpr int ASPLIT = -1;
    unsigned char* y;
    __device__ __forceinline__ void operator()(const f32x4 (&acc)[2][2][4][2], const Unit& u, int wr, int wc, int fr, int fq) const {
        const int col0 = u.pn * BM + wc * 32 + 8 * fq;
#pragma unroll
        for (int ai = 0; ai < 2; ++ai)
#pragma unroll
            for (int m = 0; m < 4; ++m) {
                unsigned char* rowp = y + (size_t)(u.tb * BM + ai * HALF + wr * 64 + m * 16 + fr) * D + col0;
#pragma unroll
                for (int bj = 0; bj < 2; ++bj) { const f32x4 v0 = acc[ai][bj][m][0], v1 = acc[ai][bj][m][1]; int w0 = 0, w1 = 0;
                    w0 = __builtin_amdgcn_cvt_pk_fp8_f32(v0[0], v0[1], w0, false); w0 = __builtin_amdgcn_cvt_pk_fp8_f32(v0[2], v0[3], w0, true);
                    w1 = __builtin_amdgcn_cvt_pk_fp8_f32(v1[0], v1[1], w1, false); w1 = __builtin_amdgcn_cvt_pk_fp8_f32(v1[2], v1[3], w1, true);
                    u32x2 o; o.x = (unsigned)w0; o.y = (unsigned)w1; *(u32x2*)(rowp + bj * HALF) = o; }
            }
    }
};
}

namespace ga {
constexpr int DH = 128, QBLK = 32, KVBLK = 64, LDQ = 2048, LDK = 512, LDO = 2048;
constexpr float SCALE = 0.088388347648318440f;
constexpr float THR = 5.f;
constexpr size_t SHM_V = KVBLK * DH * 2, SHM_K = KVBLK * DH * 2, SHM_ATTN = 2 * SHM_V + 2 * SHM_K + NWAVES * 64 * 4;
typedef float f32x16 __attribute__((ext_vector_type(16)));
#define KSWZ(row, colB) ((row) * 256 + ((colB) ^ (((row) & 7) << 4)))
#define SBAR() __builtin_amdgcn_sched_barrier(0)
__device__ __forceinline__ int crow(int r, int hi) { return (r & 3) + 8 * (r >> 2) + 4 * hi; }
__device__ __forceinline__ void partialSM(f32x16& p0, f32x16& p1, float& m_reg, float& mn, float& alpha) {
  constexpr float C = SCALE * 1.4426950408889634f;
  float pmax = p0[0]; for (int r = 1; r < 16; ++r) pmax = fmaxf(pmax, p0[r]); for (int r = 0; r < 16; ++r) pmax = fmaxf(pmax, p1[r]);
  { auto rr = __builtin_amdgcn_permlane32_swap(__float_as_uint(pmax), __float_as_uint(pmax), false, false);
    pmax = fmaxf(__uint_as_float(rr[0]), __uint_as_float(rr[1])); }
  if (__builtin_expect(__all(pmax - m_reg <= THR / SCALE), 1)) { mn = m_reg; alpha = 1.f; }
  else { mn = fmaxf(m_reg, pmax); alpha = __builtin_amdgcn_exp2f((m_reg - mn) * C); m_reg = mn; }
  float mnC = -mn * C;
  for (int r = 0; r < 16; ++r) p0[r] = fmaf(p0[r], C, mnC); for (int r = 0; r < 16; ++r) p1[r] = fmaf(p1[r], C, mnC);
  for (int r = 0; r < 16; ++r) p0[r] = __builtin_amdgcn_exp2f(p0[r]);
}
typedef int v8i_p __attribute__((ext_vector_type(8)));
__device__ __forceinline__ void finishSM(f32x16& p0, f32x16& p1, float alpha, float& l_reg, v8i_p& pf) {
  for (int r = 0; r < 16; ++r) p1[r] = __builtin_amdgcn_exp2f(p1[r]);
  float ps = 0; for (int r = 0; r < 16; ++r) ps += p0[r]; for (int r = 0; r < 16; ++r) ps += p1[r];
  { auto rr = __builtin_amdgcn_permlane32_swap(__float_as_uint(ps), __float_as_uint(ps), false, false);
    ps = __uint_as_float(rr[0]) + __uint_as_float(rr[1]); }
  l_reg = l_reg * alpha + ps;
#pragma unroll
  for (int i = 0; i < 4; ++i) { int w = 0; w = __builtin_amdgcn_cvt_pk_fp8_f32(p0[4 * i], p0[4 * i + 1], w, false); w = __builtin_amdgcn_cvt_pk_fp8_f32(p0[4 * i + 2], p0[4 * i + 3], w, true); pf[i] = w;
    int u = 0; u = __builtin_amdgcn_cvt_pk_fp8_f32(p1[4 * i], p1[4 * i + 1], u, false); u = __builtin_amdgcn_cvt_pk_fp8_f32(p1[4 * i + 2], p1[4 * i + 3], u, true); pf[4 + i] = u; }
}
typedef int v8i_a __attribute__((ext_vector_type(8)));
typedef int v4i_a __attribute__((ext_vector_type(4)));
__device__ __forceinline__ int k8_off(int row, int chunk) { return row * 128 + ((chunk ^ ((row >> 1) & 7)) << 4); }
__device__ __forceinline__ void qkt(f32x16& p0, f32x16& p1, const char* Ks, const v8i_a* q8, int r32, int hi) {
  p0 = f32x16{}; p1 = f32x16{};
#pragma unroll
  for (int m = 0; m < 2; ++m) {
    const v4i_a a0l = *reinterpret_cast<const v4i_a*>(Ks + k8_off(r32, hi * 4 + 2 * m)), a0h = *reinterpret_cast<const v4i_a*>(Ks + k8_off(r32, hi * 4 + 2 * m + 1));
    const v4i_a a1l = *reinterpret_cast<const v4i_a*>(Ks + k8_off(32 + r32, hi * 4 + 2 * m)), a1h = *reinterpret_cast<const v4i_a*>(Ks + k8_off(32 + r32, hi * 4 + 2 * m + 1));
    const v8i_a a0 = __builtin_shufflevector(a0l, a0h, 0, 1, 2, 3, 4, 5, 6, 7), a1 = __builtin_shufflevector(a1l, a1h, 0, 1, 2, 3, 4, 5, 6, 7);
    p0 = __builtin_amdgcn_mfma_scale_f32_32x32x64_f8f6f4(a0, q8[m], p0, 0, 0, 0, 127, 0, 127);
    p1 = __builtin_amdgcn_mfma_scale_f32_32x32x64_f8f6f4(a1, q8[m], p1, 0, 0, 0, 127, 0, 127); }
}
__device__ __forceinline__ int vt_off(int d, int byte) { return d * 64 + ((((byte >> 4) ^ ((d >> 2) & 3))) << 4) + (byte & 15); }
__device__ __forceinline__ int vt_pos(int k) { const int k32 = k & 31; return ((k32 >> 2) & 1) * 32 + (k >> 5) * 16 + (k32 & 3) + 4 * (k32 >> 3); }
template <int D0> __device__ __forceinline__ void pv_one(f32x16& od, const char* VT, v8i_p pf, int r32, int hi) {
  const int d = 32 * D0 + r32;
  const v4i_a bl = *reinterpret_cast<const v4i_a*>(VT + vt_off(d, 32 * hi)), bh = *reinterpret_cast<const v4i_a*>(VT + vt_off(d, 32 * hi + 16));
  od = __builtin_amdgcn_mfma_scale_f32_32x32x64_f8f6f4(pf, __builtin_shufflevector(bl, bh, 0, 1, 2, 3, 4, 5, 6, 7), od, 0, 0, 0, 127, 0, 127);
}
__device__ __forceinline__ void pv_d0(f32x16* o, const char* VT, v8i_p pf, int r32, int hi) {
  pv_one<0>(o[0], VT, pf, r32, hi); pv_one<1>(o[1], VT, pf, r32, hi); pv_one<2>(o[2], VT, pf, r32, hi); pv_one<3>(o[3], VT, pf, r32, hi);
}
__device__ __forceinline__ u32x2 k8pack(bf16x8 v) { const u32x4 w = __builtin_bit_cast(u32x4, v); int a = 0, b = 0;
  a = __builtin_amdgcn_cvt_pk_fp8_f32(bflo(w.x), bfhi(w.x), a, false); a = __builtin_amdgcn_cvt_pk_fp8_f32(bflo(w.y), bfhi(w.y), a, true); b = __builtin_amdgcn_cvt_pk_fp8_f32(bflo(w.z), bfhi(w.z), b, false); b = __builtin_amdgcn_cvt_pk_fp8_f32(bflo(w.w), bfhi(w.w), b, true);
  u32x2 o; o.x = (unsigned)a; o.y = (unsigned)b; return o; }
__device__ __forceinline__ void attn_dense_body(const bf16_t* __restrict__ Qb, const float* __restrict__ gq, const float* __restrict__ tab, int t0, const unsigned char* __restrict__ Kh, const unsigned char* __restrict__ Vh,
                                                unsigned char* __restrict__ Ob, int seq, char* lds, const int wid0) {
  const int tid = opaque_tid(wid0), wid = tid >> 6, lane = tid & 63, r32 = lane & 31, hi = lane >> 5;
  char* V_lds = lds; char* K_lds = lds + 2 * SHM_V;
  float* ws = (float*)(lds + 2 * SHM_V + 2 * SHM_K) + wid * 64; float* li_l = ws; float* al_l = ws + 32;
  float m_reg = -1e30f, l_reg = 0; f32x16 o[4] = {}; v8i_a qr[2];
  { const bf16_t* Qw = Qb + (long)(wid * QBLK + r32) * ODD_IN + hi * 8;
    u32x4 raw[8]; float ss = 0.f;
#pragma unroll
    for (int d0 = 0; d0 < 8; ++d0) { raw[d0] = *reinterpret_cast<const u32x4*>(Qw + d0 * 16);
      const float a0 = bflo(raw[d0].x), a1 = bfhi(raw[d0].x), a2 = bflo(raw[d0].y), a3 = bfhi(raw[d0].y), a4 = bflo(raw[d0].z), a5 = bfhi(raw[d0].z), a6 = bflo(raw[d0].w), a7 = bfhi(raw[d0].w);
      ss += (a0 * a0 + a1 * a1) + (a2 * a2 + a3 * a3) + (a4 * a4 + a5 * a5) + (a6 * a6 + a7 * a7); }
    ss += __shfl_xor(ss, 32);
    const float rstd = rsqrtf(ss * (1.0f / 128.0f) + EPS);
    const int t = t0 + wid * QBLK + r32, posr = t >> 6, posc = t & 63;
#pragma unroll
    for (int d0 = 0; d0 < 8; ++d0) { const int hf = d0 >> 2, pos = hf ? posc : posr, jb = 8 * (d0 & 3) + 4 * hi;
      const f32x4 cs = *(const f32x4*)(tab + pos * 32 + jb), sn = *(const f32x4*)(tab + 2048 + pos * 32 + jb), g1 = *(const f32x4*)(gq + 64 * hf + jb) * rstd, g2 = *(const f32x4*)(gq + 64 * hf + 32 + jb) * rstd;
      const unsigned rw[4] = {raw[d0].x, raw[d0].y, raw[d0].z, raw[d0].w}; float oo[8];
#pragma unroll
      for (int pi = 0; pi < 4; ++pi) { const float y1 = bflo(rw[pi]) * g1[pi], y2 = bfhi(rw[pi]) * g2[pi]; oo[2 * pi] = y1 * cs[pi] - y2 * sn[pi]; oo[2 * pi + 1] = y2 * cs[pi] + y1 * sn[pi]; }
      int wa = 0, wb = 0; wa = __builtin_amdgcn_cvt_pk_fp8_f32(oo[0], oo[1], wa, false); wa = __builtin_amdgcn_cvt_pk_fp8_f32(oo[2], oo[3], wa, true); wb = __builtin_amdgcn_cvt_pk_fp8_f32(oo[4], oo[5], wb, false); wb = __builtin_amdgcn_cvt_pk_fp8_f32(oo[6], oo[7], wb, true);
      qr[d0 >> 2][2 * (d0 & 3)] = wa; qr[d0 >> 2][2 * (d0 & 3) + 1] = wb; } }
  struct { bf16x8 vs0, ks0; } sr_[2];
#define SLOAD(i, k0) do { sr_[i].vs0 = *reinterpret_cast<const bf16x8*>(Vh + (size_t)((k0) >> 6) * 8192 + tid * 16); sr_[i].ks0 = *reinterpret_cast<const bf16x8*>(Kh + (size_t)((k0) >> 6) * 8192 + tid * 16); } while (0)
#define SWRITE(b, i) do { *(bf16x8*)(V_lds + (b) * SHM_V + tid * 16) = sr_[i].vs0; *(bf16x8*)(K_lds + (b) * SHM_K + tid * 16) = sr_[i].ks0; } while (0)
#define SWAIT() asm volatile("s_waitcnt vmcnt(2)" ::: "memory")
#define RESC(a) do { if (__any((a) < 1.f)) { if (hi == 0) al_l[r32] = (a); asm volatile("s_waitcnt lgkmcnt(0)" ::: "memory"); \
    for (int d = 0; d < 4; ++d) for (int r = 0; r < 16; ++r) o[d][r] *= al_l[crow(r, hi)]; } } while (0)
  f32x16 pA0, pA1, pB0, pB1; float mnA, mnB, alA, alB; v8i_p pf; const int NT = seq / KVBLK;
  constexpr int SE = 0, SO = 1;
  SLOAD(SE, 0); asm volatile("s_waitcnt vmcnt(0)" ::: "memory"); SWRITE(0, SE); __syncthreads();
  qkt(pA0, pA1, K_lds, qr, r32, hi); partialSM(pA0, pA1, m_reg, mnA, alA);
  SLOAD(SO, KVBLK); if (2 < NT) SLOAD(SE, 2 * KVBLK);
  SWAIT(); SWRITE(1, SO); __syncthreads();
  for (int j = 1; j + 1 < NT; j += 2) {
    SBAR(); qkt(pB0, pB1, K_lds + SHM_K, qr, r32, hi);
    finishSM(pA0, pA1, alA, l_reg, pf); SBAR();
    SLOAD(SO, (j + 2) * KVBLK); SBAR();
    pv_d0(o, V_lds, pf, r32, hi); partialSM(pB0, pB1, m_reg, mnB, alB);
    __syncthreads(); SWAIT(); SWRITE(0, SE);
    RESC(alB); __syncthreads();
    SBAR(); qkt(pA0, pA1, K_lds, qr, r32, hi);
    finishSM(pB0, pB1, alB, l_reg, pf); SBAR();
    if (j + 3 < NT) SLOAD(SE, (j + 3) * KVBLK); SBAR();
    pv_d0(o, V_lds + SHM_V, pf, r32, hi); partialSM(pA0, pA1, m_reg, mnA, alA);
    __syncthreads(); SWAIT(); SWRITE(1, SO);
    RESC(alA); __syncthreads();
  }
  SBAR(); qkt(pB0, pB1, K_lds + SHM_K, qr, r32, hi);
  finishSM(pA0, pA1, alA, l_reg, pf); SBAR();
  pv_d0(o, V_lds, pf, r32, hi); partialSM(pB0, pB1, m_reg, mnB, alB);
  __syncthreads(); RESC(alB);
  finishSM(pB0, pB1, alB, l_reg, pf); SBAR();
  pv_d0(o, V_lds + SHM_V, pf, r32, hi);
  if (hi == 0) li_l[r32] = l_reg; asm volatile("s_waitcnt lgkmcnt(0)" ::: "memory");
  float rli[16];
#pragma unroll
  for (int r = 0; r < 16; ++r) rli[r] = __builtin_amdgcn_rcpf(li_l[crow(r, hi)]);
  unsigned char* Ow = Ob + (long)(wid * QBLK) * LDO;
#pragma unroll
  for (int r = 0; r < 16; ++r) { int orow = crow(r, hi);
    for (int d0 = 0; d0 < 4; ++d0) Ow[(long)orow * LDO + d0 * 32 + r32] = f2fp8(o[d0][r] * rli[r] * 16.0f); }
  __syncthreads();
#undef SLOAD
#undef SWRITE
#undef SWAIT
#undef RESC
}
}

__device__ __forceinline__ void win_attn_item(char* lds, const bf16_t* __restrict__ P, bf16_t* __restrict__ cat, const float* __restrict__ sink, int b, int h, int qb, bool isctx, const int wid0) {
    const int tid = opaque_tid(wid0), wid = tid >> 6, lane = tid & 63, lq = lane & 15, g = lane >> 4;
    const int kvh = h >> 3;
    char* Ks = lds; char* Vs = lds + 128 * 144;
    const size_t qrow0 = isctx ? (size_t)(TL + b * CTXL + qb * 128) : (size_t)(b * SEQ + qb * 128);
    const bf16_t* qp = P + (qrow0 + wid * 16 + lq) * EVEN_IN + 5120 + h * 64 + 8 * g;
    const bf16x8 qf0 = *(const bf16x8*)qp, qf1 = *(const bf16x8*)(qp + 32);
    float m = sink[h], l = 1.0f;
    f32x4 o[4];
#pragma unroll
    for (int dt = 0; dt < 4; ++dt) o[dt] = (f32x4){0.f, 0.f, 0.f, 0.f};
    const int ntile = isctx ? 2 : 5;
    const int iq = wid * 16 + lq;
    for (int ti = 0; ti < ntile; ++ti) {
        int kind; size_t krow0;
        if (isctx) { kind = 3; krow0 = (size_t)(TL + b * CTXL + ti * 128); }
        else if (ti < 3) { const int kbi = qb - 1 + ti; if (kbi < 0 || kbi >= SEQ / 128) continue; kind = ti; krow0 = (size_t)(b * SEQ + kbi * 128); }
        else { kind = 3; krow0 = (size_t)(TL + b * CTXL + (ti - 3) * 128); }
        __syncthreads();
        { const int r = tid >> 2, c = (tid & 3) * 16; const bf16_t* kp = P + (krow0 + r) * EVEN_IN + 6144 + kvh * 64 + c; const bf16_t* vp = kp + 128;
          const bf16x8 k0 = *(const bf16x8*)kp, k1 = *(const bf16x8*)(kp + 8), v0 = *(const bf16x8*)vp, v1 = *(const bf16x8*)(vp + 8);
          *(bf16x8*)(Ks + r * 144 + c * 2) = k0; *(bf16x8*)(Ks + r * 144 + c * 2 + 16) = k1;
          *(bf16x8*)(Vs + r * 144 + c * 2) = v0; *(bf16x8*)(Vs + r * 144 + c * 2 + 16) = v1; }
        __syncthreads();
        f32x4 st[8];
#pragma unroll
        for (int kt = 0; kt < 8; ++kt) {
            const bf16x8 kf0 = *(const bf16x8*)(Ks + (16 * kt + lq) * 144 + 16 * g), kf1 = *(const bf16x8*)(Ks + (16 * kt + lq) * 144 + 64 + 16 * g);
            f32x4 a = (f32x4){0.f, 0.f, 0.f, 0.f};
            a = __builtin_amdgcn_mfma_f32_16x16x32_bf16(kf0, qf0, a, 0, 0, 0);
            a = __builtin_amdgcn_mfma_f32_16x16x32_bf16(kf1, qf1, a, 0, 0, 0);
            st[kt] = a;
        }
        float tm = -INFINITY;
#pragma unroll
        for (int kt = 0; kt < 8; ++kt)
#pragma unroll
            for (int i = 0; i < 4; ++i) { float s = st[kt][i] * 0.125f; const int jj = 16 * kt + 4 * g + i;
                if (kind == 0 && jj < iq) s = -INFINITY; if (kind == 2 && jj > iq) s = -INFINITY; st[kt][i] = s; tm = fmaxf(tm, s); }
        tm = fmaxf(tm, __shfl_xor(tm, 16)); tm = fmaxf(tm, __shfl_xor(tm, 32));
        const float mn = fmaxf(m, tm), alpha = __expf(m - mn); m = mn;
        float ps = 0.f;
#pragma unroll
        for (int kt = 0; kt < 8; ++kt)
#pragma unroll
            for (int i = 0; i < 4; ++i) { const float p = __expf(st[kt][i] - mn); st[kt][i] = p; ps += p; }
        ps += __shfl_xor(ps, 16); ps += __shfl_xor(ps, 32);
        l = l * alpha + ps;
#pragma unroll
        for (int i = 0; i < 4; ++i) { const float a = __shfl(alpha, 4 * g + i);
#pragma unroll
            for (int dt = 0; dt < 4; ++dt) o[dt][i] *= a; }
#pragma unroll
        for (int tp = 0; tp < 4; ++tp) {
            u32x4 pw; pw.x = cvt_pk(st[2 * tp][0], st[2 * tp][1]); pw.y = cvt_pk(st[2 * tp][2], st[2 * tp][3]); pw.z = cvt_pk(st[2 * tp + 1][0], st[2 * tp + 1][1]); pw.w = cvt_pk(st[2 * tp + 1][2], st[2 * tp + 1][3]);
            const bf16x8 pf = *reinterpret_cast<bf16x8*>(&pw);
#pragma unroll
            for (int dt = 0; dt < 4; ++dt) {
                const s16x4 v0 = __builtin_amdgcn_ds_read_tr16_b64_v4i16((LAS s16x4*)(Vs + (32 * tp + 4 * g + (lq >> 2)) * 144 + (16 * dt + 4 * (lq & 3)) * 2));
                const s16x4 v1 = __builtin_amdgcn_ds_read_tr16_b64_v4i16((LAS s16x4*)(Vs + (32 * tp + 16 + 4 * g + (lq >> 2)) * 144 + (16 * dt + 4 * (lq & 3)) * 2));
                const bf16x8 vf = (bf16x8){v0[0], v0[1], v0[2], v0[3], v1[0], v1[1], v1[2], v1[3]};
                o[dt] = __builtin_amdgcn_mfma_f32_16x16x32_bf16(pf, vf, o[dt], 0, 0, 0);
            }
        }
    }
#pragma unroll
    for (int i = 0; i < 4; ++i) { const float inv = 1.0f / __shfl(l, 4 * g + i);
        bf16_t* op = cat + (qrow0 + wid * 16 + 4 * g + i) * D + 1024 + h * 64 + lq;
#pragma unroll
        for (int dt = 0; dt < 4; ++dt) op[16 * dt] = f2bf(o[dt][i] * inv); }
}

__device__ __forceinline__ void win_attn_item2(char* lds, const bf16_t* __restrict__ P, unsigned char* __restrict__ cat, const float* __restrict__ sink, int b, int kvh, int qb, bool isctx, const int wid0) {
    const int tid = opaque_tid(wid0), wid = tid >> 6, lane = tid & 63, lq = lane & 15, g = lane >> 4;
    const int h = kvh * 8 + wid;
    char* Ks = lds; char* Vs = lds + 64 * 144;
    const size_t qrow0 = isctx ? (size_t)(TL + b * CTXL + qb * 64) : (size_t)(b * SEQ + qb * 64);
    const int q0 = qb * 64;
    bf16x8 qf[4][2];
#pragma unroll
    for (int qt = 0; qt < 4; ++qt) { const bf16_t* qp = P + (qrow0 + 16 * qt + lq) * EVEN_IN + 5120 + h * 64 + 8 * g; qf[qt][0] = *(const bf16x8*)qp; qf[qt][1] = *(const bf16x8*)(qp + 32); }
    float m[4], l[4]; f32x4 o[4][4];
    const float sk = sink[h];
#pragma unroll
    for (int qt = 0; qt < 4; ++qt) { m[qt] = sk; l[qt] = 1.0f;
#pragma unroll
        for (int dt = 0; dt < 4; ++dt) o[qt][dt] = (f32x4){0.f, 0.f, 0.f, 0.f}; }
    const int ntile = isctx ? 4 : 9;
    for (int ti = 0; ti < ntile; ++ti) {
        bool win = false; int kpos0 = 0; size_t krow0;
        if (isctx) krow0 = (size_t)(TL + b * CTXL + ti * 64);
        else if (ti < 5) { win = true; kpos0 = q0 - 128 + 64 * ti; if (kpos0 < 0 || kpos0 >= SEQ) continue; krow0 = (size_t)(b * SEQ + kpos0); }
        else krow0 = (size_t)(TL + b * CTXL + (ti - 5) * 64);
        __syncthreads();
        { const int r = tid >> 3, c = (tid & 7) * 8; const bf16_t* kp = P + (krow0 + r) * EVEN_IN + 6144 + kvh * 64 + c;
          *(bf16x8*)(Ks + r * 144 + c * 2) = *(const bf16x8*)kp; *(bf16x8*)(Vs + r * 144 + c * 2) = *(const bf16x8*)(kp + 128); }
        __syncthreads();
        bf16x8 kf[4][2], vf[2][4];
#pragma unroll
        for (int kt = 0; kt < 4; ++kt) { kf[kt][0] = *(const bf16x8*)(Ks + (16 * kt + lq) * 144 + 16 * g); kf[kt][1] = *(const bf16x8*)(Ks + (16 * kt + lq) * 144 + 64 + 16 * g); }
#pragma unroll
        for (int ks = 0; ks < 2; ++ks)
#pragma unroll
            for (int dt = 0; dt < 4; ++dt) {
                const s16x4 v0 = __builtin_amdgcn_ds_read_tr16_b64_v4i16((LAS s16x4*)(Vs + (32 * ks + 4 * g + (lq >> 2)) * 144 + (16 * dt + 4 * (lq & 3)) * 2));
                const s16x4 v1 = __builtin_amdgcn_ds_read_tr16_b64_v4i16((LAS s16x4*)(Vs + (32 * ks + 16 + 4 * g + (lq >> 2)) * 144 + (16 * dt + 4 * (lq & 3)) * 2));
                vf[ks][dt] = (bf16x8){v0[0], v0[1], v0[2], v0[3], v1[0], v1[1], v1[2], v1[3]}; }
#pragma unroll
        for (int qt = 0; qt < 4; ++qt) {
            f32x4 st[4];
#pragma unroll
            for (int kt = 0; kt < 4; ++kt) { f32x4 a = (f32x4){0.f, 0.f, 0.f, 0.f};
                a = __builtin_amdgcn_mfma_f32_16x16x32_bf16(kf[kt][0], qf[qt][0], a, 0, 0, 0); a = __builtin_amdgcn_mfma_f32_16x16x32_bf16(kf[kt][1], qf[qt][1], a, 0, 0, 0); st[kt] = a; }
            const int qpos = q0 + 16 * qt + lq;
            float tm = -INFINITY;
#pragma unroll
            for (int kt = 0; kt < 4; ++kt)
#pragma unroll
                for (int i = 0; i < 4; ++i) { float sc = st[kt][i] * 0.125f;
                    if (win) { const int d = kpos0 + 16 * kt + 4 * g + i - qpos; if (d < -128 || d > 128) sc = -INFINITY; }
                    st[kt][i] = sc; tm = fmaxf(tm, sc); }
            tm = fmaxf(tm, __shfl_xor(tm, 16)); tm = fmaxf(tm, __shfl_xor(tm, 32));
            const float mn = fmaxf(m[qt], tm), alpha = __expf(m[qt] - mn); m[qt] = mn;
            float ps = 0.f;
#pragma unroll
            for (int kt = 0; kt < 4; ++kt)
#pragma unroll
                for (int i = 0; i < 4; ++i) { const float p = __expf(st[kt][i] - mn); st[kt][i] = p; ps += p; }
            ps += __shfl_xor(ps, 16); ps += __shfl_xor(ps, 32);
            l[qt] = l[qt] * alpha + ps;
#pragma unroll
            for (int i = 0; i < 4; ++i) { const float a = __shfl(alpha, 4 * g + i);
#pragma unroll
                for (int dt = 0; dt < 4; ++dt) o[qt][dt][i] *= a; }
#pragma unroll
            for (int ks = 0; ks < 2; ++ks) {
                u32x4 pw; pw.x = cvt_pk(st[2 * ks][0], st[2 * ks][1]); pw.y = cvt_pk(st[2 * ks][2], st[2 * ks][3]); pw.z = cvt_pk(st[2 * ks + 1][0], st[2 * ks + 1][1]); pw.w = cvt_pk(st[2 * ks + 1][2], st[2 * ks + 1][3]);
                const bf16x8 pf = *reinterpret_cast<bf16x8*>(&pw);
#pragma unroll
                for (int dt = 0; dt < 4; ++dt) o[qt][dt] = __builtin_amdgcn_mfma_f32_16x16x32_bf16(pf, vf[ks][dt], o[qt][dt], 0, 0, 0);
            }
        }
    }
#pragma unroll
    for (int qt = 0; qt < 4; ++qt)
#pragma unroll
        for (int i = 0; i < 4; ++i) { const float inv = 1.0f / __shfl(l[qt], 4 * g + i);
            unsigned char* op = cat + (qrow0 + 16 * qt + 4 * g + i) * D + 1024 + h * 64 + lq;
#pragma unroll
            for (int dt = 0; dt < 4; ++dt) op[16 * dt] = f2fp8(o[qt][dt][i] * inv * 16.0f); }
}

__device__ __forceinline__ float hgrn_lb(const float* __restrict__ lbl, int kk) {
    const float l0 = lbl[kk], l1 = lbl[1024 + kk], l2 = lbl[2048 + kk], mx = fmaxf(l0, fmaxf(l1, l2));
    const float e0 = __expf(l0 - mx), e1 = __expf(l1 - mx), e2 = __expf(l2 - mx);
    return e1 / (e0 + e1 + e2);
}
__device__ __forceinline__ size_t chunk_row0(int b, int ci) { return ci < 64 ? (size_t)(b * SEQ + ci * 64) : (size_t)(TL + b * CTXL + (ci - 64) * 64); }
__device__ __forceinline__ void hgrn_a_item(char* lds, const bf16_t* __restrict__ P, const float* __restrict__ lbl, bf16_t* __restrict__ U, float* __restrict__ DEC, int b, int h, int ci, const int wid0) {
    const int tid = opaque_tid(wid0), wid = tid >> 6, lane = tid & 63, lq = lane & 15, g = lane >> 4;
    const size_t r0 = chunk_row0(b, ci);
    char* WT = lds; char* Vs = lds + 2 * 128 * 144;
    __syncthreads();
    char* FR = lds + 2 * 128 * 144 + 64 * 272;
    {
        const int r = tid >> 3, c = (tid & 7) * 16;
        const bf16_t* vp = P + (r0 + r) * EVEN_IN + 1024 + h * 128 + c;
        const bf16x8 v0 = *(const bf16x8*)vp, v1 = *(const bf16x8*)(vp + 8), a0 = *(const bf16x8*)(vp + 1024), a1 = *(const bf16x8*)(vp + 1032), b0 = *(const bf16x8*)(vp + 2048), b1 = *(const bf16x8*)(vp + 2056);
        *(bf16x8*)(Vs + r * 272 + c * 2) = v0; *(bf16x8*)(Vs + r * 272 + c * 2 + 16) = v1;
        *(bf16x8*)(FR + r * 272 + c * 2) = a0; *(bf16x8*)(FR + r * 272 + c * 2 + 16) = a1;
        *(bf16x8*)(FR + 17408 + r * 272 + c * 2) = b0; *(bf16x8*)(FR + 17408 + r * 272 + c * 2 + 16) = b1;
    }
    __syncthreads();
    {
        const int dir = tid >> 8, k = (tid >> 1) & 127, half = tid & 1, kk = h * 128 + k, s0 = half * 32;
        const float lb = hgrn_lb(lbl, kk);
        const char* fp = FR + dir * 17408 + s0 * 272 + k * 2;
        float f[32], kf[32];
#pragma unroll
        for (int s = 0; s < 32; ++s) f[s] = bf2f(*(const bf16_t*)(fp + s * 272));
        float mine = 0.f;
#pragma unroll
        for (int s = 0; s < 32; ++s) { const float g = lb + (1.0f - lb) * sigmoidf_(f[s]); kf[s] = 1.0f - g; f[s] = __builtin_amdgcn_logf(g); mine += f[s]; }
        const float other = __shfl_xor(mine, 1), tot = mine + other;
        char* wrow = WT + (dir * 128 + k) * 144 + s0 * 2;
        if (dir == 0) {
            float bs = half ? other : 0.f;
#pragma unroll
            for (int s = 0; s < 32; ++s) { bs += f[s]; const float w = kf[s] * __builtin_amdgcn_exp2f(tot - bs); *(bf16_t*)(wrow + s * 2) = f2bf(w); }
        } else {
            float bs = half ? 0.f : other;
#pragma unroll
            for (int s = 31; s >= 0; --s) { bs += f[s]; const float w = kf[s] * __builtin_amdgcn_exp2f(tot - bs); *(bf16_t*)(wrow + s * 2) = f2bf(w); }
        }
        if (half == 0) DEC[((size_t)((b * 8 + h) * 2 + dir) * NCHK + ci) * 128 + k] = __builtin_amdgcn_exp2f(tot);
    }
    __syncthreads();
    bf16x8 vf[2];
#pragma unroll
    for (int ks = 0; ks < 2; ++ks) {
        const s16x4 v0 = __builtin_amdgcn_ds_read_tr16_b64_v4i16((LAS s16x4*)(Vs + (32 * ks + 8 * g + (lq >> 2)) * 272 + (16 * wid + 4 * (lq & 3)) * 2));
        const s16x4 v1 = __builtin_amdgcn_ds_read_tr16_b64_v4i16((LAS s16x4*)(Vs + (32 * ks + 8 * g + 4 + (lq >> 2)) * 272 + (16 * wid + 4 * (lq & 3)) * 2));
        vf[ks] = (bf16x8){v0[0], v0[1], v0[2], v0[3], v1[0], v1[1], v1[2], v1[3]};
    }
#pragma unroll
    for (int dir = 0; dir < 2; ++dir) {
        bf16_t* up = U + (((size_t)((b * 8 + h) * 2 + dir) * NCHK + ci) * 128 + 16 * wid + lq) * 128 + 4 * g;
#pragma unroll
        for (int kt = 0; kt < 8; ++kt) {
            f32x4 a = (f32x4){0.f, 0.f, 0.f, 0.f};
#pragma unroll
            for (int ks = 0; ks < 2; ++ks) { const bf16x8 wf = *(const bf16x8*)(WT + (dir * 128 + 16 * kt + lq) * 144 + (32 * ks + 8 * g) * 2); a = __builtin_amdgcn_mfma_f32_16x16x32_bf16(wf, vf[ks], a, 0, 0, 0); }
            u32x2 w; w.x = cvt_pk(a[0], a[1]); w.y = cvt_pk(a[2], a[3]); *(u32x2*)(up + 16 * kt) = w;
        }
    }
}
__device__ __forceinline__ void hgrn_b_phase(const bf16_t* __restrict__ U, const float* __restrict__ DEC, bf16_t* __restrict__ Sb, const int wid0) {
    for (int idx = blockIdx.x * 512 + opaque_tid(wid0); idx < 64 * 2048; idx += gridDim.x * 512) {
        const int seq = idx >> 11, rem = idx & 2047, v = rem >> 4, k8 = rem & 15, dir = seq & 1;
        float st[8];
#pragma unroll
        for (int j = 0; j < 8; ++j) st[j] = 0.f;
#pragma unroll 4
        for (int p = 0; p < NCHK; ++p) {
            const int ci = dir == 0 ? (p < 4 ? 64 + p : p - 4) : (p < 4 ? 67 - p : 67 - p);
            const size_t cb = (size_t)seq * NCHK + ci, off = (cb * 128 + v) * 128 + k8 * 8;
            const u32x4 u = *(const u32x4*)(U + off);
            const f32x4 d0 = *(const f32x4*)(DEC + cb * 128 + k8 * 8), d1 = *(const f32x4*)(DEC + cb * 128 + k8 * 8 + 4);
            u32x4 sw; sw.x = cvt_pk(st[0], st[1]); sw.y = cvt_pk(st[2], st[3]); sw.z = cvt_pk(st[4], st[5]); sw.w = cvt_pk(st[6], st[7]);
            *(u32x4*)(Sb + off) = sw;
            st[0] = d0[0] * st[0] + bflo(u.x); st[1] = d0[1] * st[1] + bfhi(u.x); st[2] = d0[2] * st[2] + bflo(u.y); st[3] = d0[3] * st[3] + bfhi(u.y);
            st[4] = d1[0] * st[4] + bflo(u.z); st[5] = d1[1] * st[5] + bfhi(u.z); st[6] = d1[2] * st[6] + bflo(u.w); st[7] = d1[3] * st[7] + bfhi(u.w);
        }
    }
}
__device__ __forceinline__ void hgrn_c_item(char* lds, const bf16_t* __restrict__ P, const float* __restrict__ lbl, const bf16_t* __restrict__ Sb, const float* __restrict__ gain, unsigned char* __restrict__ cat, int b, int h, int ci, const int wid0) {
    const int tid = opaque_tid(wid0), wid = tid >> 6, lane = tid & 63, lq = lane & 15, g = lane >> 4;
    const size_t r0 = chunk_row0(b, ci);
    char* QD = lds; char* QA = lds + 34816; char* KA = lds + 69632; char* ATT = lds + 104448; char* Vs = lds + 122880; float* SSW = (float*)(lds + 140288);
    __syncthreads();
    {
        const int r = tid >> 3, c = (tid & 7) * 16;
        const bf16_t* vp = P + (r0 + r) * EVEN_IN + 1024 + h * 128 + c;
        *(bf16x8*)(Vs + r * 272 + c * 2) = *(const bf16x8*)vp; *(bf16x8*)(Vs + r * 272 + c * 2 + 16) = *(const bf16x8*)(vp + 8);
    }
    {
        const int dir = tid >> 8, k = (tid >> 1) & 127, half = tid & 1, kk = h * 128 + k, s0 = half * 32;
        const float lb = hgrn_lb(lbl, kk);
        const bf16_t* fp = P + (r0 + s0) * EVEN_IN + (dir ? 3072 : 2048) + kk;
        const bf16_t* qp = P + (r0 + s0) * EVEN_IN + kk;
        float f[32], kf[32], q[32];
#pragma unroll
        for (int s = 0; s < 32; ++s) { f[s] = bf2f(fp[(size_t)s * EVEN_IN]); q[s] = bf2f(qp[(size_t)s * EVEN_IN]); }
        float mine = 0.f;
#pragma unroll
        for (int s = 0; s < 32; ++s) { const float g = lb + (1.0f - lb) * sigmoidf_(f[s]); kf[s] = 1.0f - g; f[s] = __builtin_amdgcn_logf(g); q[s] = siluf_(q[s]); mine += f[s]; }
        const float other = __shfl_xor(mine, 1);
        char* qd = QD + dir * 17408 + s0 * 272 + k * 2; char* qa = QA + dir * 17408 + s0 * 272 + k * 2; char* ka = KA + dir * 17408 + s0 * 272 + k * 2;
        if (dir == 0) {
            const float bm = half ? other : mine, ebm = __builtin_amdgcn_exp2f(bm); float bs = half ? other : 0.f;
#pragma unroll
            for (int s = 0; s < 32; ++s) { bs += f[s]; const float qe = q[s] * __builtin_amdgcn_exp2f(bs - bm);
                *(bf16_t*)(qd + s * 272) = f2bf(qe * ebm); *(bf16_t*)(qa + s * 272) = f2bf(qe); *(bf16_t*)(ka + s * 272) = f2bf(kf[s] * __builtin_amdgcn_exp2f(bm - bs)); }
        } else {
            const float bm = half ? mine : other, ebm = __builtin_amdgcn_exp2f(bm); float bs = half ? 0.f : other;
#pragma unroll
            for (int s = 31; s >= 0; --s) { bs += f[s]; const float qe = q[s] * __builtin_amdgcn_exp2f(bs - bm);
                *(bf16_t*)(qd + s * 272) = f2bf(qe * ebm); *(bf16_t*)(qa + s * 272) = f2bf(qe); *(bf16_t*)(ka + s * 272) = f2bf(kf[s] * __builtin_amdgcn_exp2f(bm - bs)); }
        }
    }
    __syncthreads();
    {
        const int dir = wid >> 2, tt = wid & 3;
        bf16x8 af[4];
#pragma unroll
        for (int ks = 0; ks < 4; ++ks) af[ks] = *(const bf16x8*)(QA + dir * 17408 + (16 * tt + lq) * 272 + (32 * ks + 8 * g) * 2);
#pragma unroll
        for (int stl = 0; stl < 4; ++stl) {
            f32x4 a = (f32x4){0.f, 0.f, 0.f, 0.f};
            const bool skip = dir == 0 ? (stl > tt) : (stl < tt);
            if (!skip) {
#pragma unroll
                for (int ks = 0; ks < 4; ++ks) { const bf16x8 kf = *(const bf16x8*)(KA + dir * 17408 + (16 * stl + lq) * 272 + (32 * ks + 8 * g) * 2); a = __builtin_amdgcn_mfma_f32_16x16x32_bf16(af[ks], kf, a, 0, 0, 0); }
            }
            const int s = 16 * stl + lq;
#pragma unroll
            for (int i = 0; i < 4; ++i) { const int t = 16 * tt + 4 * g + i; const bool keep = !skip && (dir == 0 ? (s <= t) : (s >= t));
                *(bf16_t*)(ATT + dir * 9216 + t * 144 + s * 2) = keep ? f2bf(a[i]) : (bf16_t)0; }
        }
    }
    __syncthreads();
    f32x4 o[4];
#pragma unroll
    for (int tt = 0; tt < 4; ++tt) o[tt] = (f32x4){0.f, 0.f, 0.f, 0.f};
    bf16x8 vf[2];
#pragma unroll
    for (int ks = 0; ks < 2; ++ks) {
        const s16x4 v0 = __builtin_amdgcn_ds_read_tr16_b64_v4i16((LAS s16x4*)(Vs + (32 * ks + 8 * g + (lq >> 2)) * 272 + (16 * wid + 4 * (lq & 3)) * 2));
        const s16x4 v1 = __builtin_amdgcn_ds_read_tr16_b64_v4i16((LAS s16x4*)(Vs + (32 * ks + 8 * g + 4 + (lq >> 2)) * 272 + (16 * wid + 4 * (lq & 3)) * 2));
        vf[ks] = (bf16x8){v0[0], v0[1], v0[2], v0[3], v1[0], v1[1], v1[2], v1[3]};
    }
#pragma unroll
    for (int dir = 0; dir < 2; ++dir) {
        const bf16_t* sp = Sb + (((size_t)((b * 8 + h) * 2 + dir) * NCHK + ci) * 128 + 16 * wid + lq) * 128 + 8 * g;
        bf16x8 sf[4];
#pragma unroll
        for (int ks = 0; ks < 4; ++ks) sf[ks] = *(const bf16x8*)(sp + 32 * ks);
#pragma unroll
        for (int tt = 0; tt < 4; ++tt) {
#pragma unroll
            for (int ks = 0; ks < 4; ++ks) { const bf16x8 qf = *(const bf16x8*)(QD + dir * 17408 + (16 * tt + lq) * 272 + (32 * ks + 8 * g) * 2); o[tt] = __builtin_amdgcn_mfma_f32_16x16x32_bf16(qf, sf[ks], o[tt], 0, 0, 0); }
#pragma unroll
            for (int ks = 0; ks < 2; ++ks) { const bf16x8 pf = *(const bf16x8*)(ATT + dir * 9216 + (16 * tt + lq) * 144 + (32 * ks + 8 * g) * 2); o[tt] = __builtin_amdgcn_mfma_f32_16x16x32_bf16(pf, vf[ks], o[tt], 0, 0, 0); }
        }
    }
#pragma unroll
    for (int tt = 0; tt < 4; ++tt)
#pragma unroll
        for (int i = 0; i < 4; ++i) { float p = o[tt][i] * o[tt][i]; p += __shfl_xor(p, 1); p += __shfl_xor(p, 2); p += __shfl_xor(p, 4); p += __shfl_xor(p, 8);
            if (lq == 0) SSW[wid * 64 + 16 * tt + 4 * g + i] = p; }
    __syncthreads();
    const float gn = gain[16 * wid + lq];
#pragma unroll
    for (int tt = 0; tt < 4; ++tt)
#pragma unroll
        for (int i = 0; i < 4; ++i) { const int t = 16 * tt + 4 * g + i; float ss = 0.f;
#pragma unroll
            for (int w = 0; w < 8; ++w) ss += SSW[w * 64 + t];
            const float rstd = rsqrtf(ss * (1.0f / 128.0f) + EPS);
            const size_t row = r0 + t; const float graw = bf2f(P[row * EVEN_IN + 4096 + h * 128 + 16 * wid + lq]);
            cat[row * D + h * 128 + 16 * wid + lq] = f2fp8(o[tt][i] * rstd * gn * siluf_(graw)); }
}

__device__ __forceinline__ void norm_mod_rows(const float* __restrict__ src_lat, const float* __restrict__ src_ctx, int nrows, const float* __restrict__ gain,
                                              const float* __restrict__ mods_l, int sh_chunk, int sc_chunk, unsigned char* __restrict__ H, int gw, int NGW, int lane) {
    for (int r = gw; r < nrows; r += NGW) {
        const float* xr = r < TL ? src_lat + (size_t)r * D : src_ctx + (size_t)(r - TL) * D; const int rt = r < TL ? (r >> 12) : 4;
        f32x4 v[8]; float ss = 0.f;
#pragma unroll
        for (int j = 0; j < 8; ++j) { v[j] = *(const f32x4*)(xr + 4 * lane + 256 * j); ss += (v[j][0] * v[j][0] + v[j][1] * v[j][1]) + (v[j][2] * v[j][2] + v[j][3] * v[j][3]); }
        const float rstd = rsqrtf(wave_sum(ss) * (1.0f / D) + EPS);
        const float* mp = mods_l + (size_t)rt * MODW;
#pragma unroll
        for (int j = 0; j < 8; ++j) { const int col = 4 * lane + 256 * j;
            const f32x4 gg = *(const f32x4*)(gain + col), sc = *(const f32x4*)(mp + sc_chunk * D + col), sh = *(const f32x4*)(mp + sh_chunk * D + col);
            const f32x4 y = v[j] * rstd * gg * (sc + 1.0f) + sh;
            int w = 0; w = __builtin_amdgcn_cvt_pk_fp8_f32(y[0], y[1], w, false); w = __builtin_amdgcn_cvt_pk_fp8_f32(y[2], y[3], w, true); *(int*)(H + (size_t)r * D + col) = w; }
    }
}
__device__ __forceinline__ void norm2_router(int nrows, const bf16_t* __restrict__ x1, const float* __restrict__ gain, const float* __restrict__ mods_l, unsigned char* __restrict__ H8,
                                             const bf16_t* __restrict__ wrhi, const bf16_t* __restrict__ wrlo, const float* __restrict__ brt, unsigned* cnt, int* __restrict__ list, float* __restrict__ wts, int* __restrict__ sloti,
                                             char* lds, int vcu, int G, int wid, int lane) {
    const int lq = lane & 15, g = lane >> 4;
    float* ssp = (float*)lds;
    float* plog = (float*)(lds + 1024);
    const float bias = brt[lane];
    for (int tile = vcu; tile < nrows / 32; tile += G) {
        const int row0 = tile * 32; const int rt = row0 < TL ? (row0 >> 12) : 4;
        const int kbase = wid * 256 + 8 * g;
        float ssq[2];
#pragma unroll
        for (int mt = 0; mt < 2; ++mt) { const bf16_t* xr = x1 + (size_t)(row0 + 16 * mt + lq) * D + kbase; float a = 0.f;
#pragma unroll
            for (int ks = 0; ks < 8; ++ks) { const u32x4 w = *(const u32x4*)(xr + 32 * ks);
                const float u0 = bflo(w.x), u1 = bfhi(w.x), u2 = bflo(w.y), u3 = bfhi(w.y), u4 = bflo(w.z), u5 = bfhi(w.z), u6 = bflo(w.w), u7 = bfhi(w.w);
                a += (u0 * u0 + u1 * u1) + (u2 * u2 + u3 * u3) + (u4 * u4 + u5 * u5) + (u6 * u6 + u7 * u7); }
            a += __shfl_xor(a, 16); a += __shfl_xor(a, 32); ssq[mt] = a; }
        __syncthreads();
        if (g == 0) { ssp[wid * 32 + lq] = ssq[0]; ssp[wid * 32 + 16 + lq] = ssq[1]; }
        __syncthreads();
        float rstd[2];
#pragma unroll
        for (int mt = 0; mt < 2; ++mt) { float t = 0.f;
#pragma unroll
            for (int w = 0; w < 8; ++w) t += ssp[w * 32 + 16 * mt + lq];
            rstd[mt] = rsqrtf(t * (1.0f / D) + EPS); }
        const float* mp = mods_l + (size_t)rt * MODW;
        f32x4 acc[2][4];
#pragma unroll
        for (int mt = 0; mt < 2; ++mt)
#pragma unroll
            for (int et = 0; et < 4; ++et) acc[mt][et] = (f32x4){0.f, 0.f, 0.f, 0.f};
#pragma unroll 2
        for (int ks = 0; ks < 8; ++ks) {
            const int col = kbase + 32 * ks;
            f32x4 ga[2], sa[2], ha[2];
#pragma unroll
            for (int q = 0; q < 2; ++q) { ga[q] = *(const f32x4*)(gain + col + 4 * q); sa[q] = *(const f32x4*)(mp + 4 * D + col + 4 * q) + 1.0f; ha[q] = *(const f32x4*)(mp + 3 * D + col + 4 * q); }
            bf16x8 whi[4], wlo[4];
#pragma unroll
            for (int et = 0; et < 4; ++et) { whi[et] = *(const bf16x8*)(wrhi + (size_t)(16 * et + lq) * D + col); wlo[et] = *(const bf16x8*)(wrlo + (size_t)(16 * et + lq) * D + col); }
#pragma unroll
            for (int mt = 0; mt < 2; ++mt) {
                float hv[8]; const u32x4 xw = *(const u32x4*)(x1 + (size_t)(row0 + 16 * mt + lq) * D + col);
#pragma unroll
                for (int q = 0; q < 2; ++q) { const f32x4 xq = q == 0 ? (f32x4){bflo(xw.x), bfhi(xw.x), bflo(xw.y), bfhi(xw.y)} : (f32x4){bflo(xw.z), bfhi(xw.z), bflo(xw.w), bfhi(xw.w)}; const f32x4 y = xq * rstd[mt] * ga[q] * sa[q] + ha[q]; hv[4 * q] = y[0]; hv[4 * q + 1] = y[1]; hv[4 * q + 2] = y[2]; hv[4 * q + 3] = y[3]; }
                { int w0 = 0, w1 = 0; w0 = __builtin_amdgcn_cvt_pk_fp8_f32(hv[0], hv[1], w0, false); w0 = __builtin_amdgcn_cvt_pk_fp8_f32(hv[2], hv[3], w0, true);
                  w1 = __builtin_amdgcn_cvt_pk_fp8_f32(hv[4], hv[5], w1, false); w1 = __builtin_amdgcn_cvt_pk_fp8_f32(hv[6], hv[7], w1, true);
                  u32x2 h8; h8.x = (unsigned)w0; h8.y = (unsigned)w1; *(u32x2*)(H8 + (size_t)(row0 + 16 * mt + lq) * D + col) = h8; }
                u32x4 hw; hw.x = cvt_pk(hv[0], hv[1]); hw.y = cvt_pk(hv[2], hv[3]); hw.z = cvt_pk(hv[4], hv[5]); hw.w = cvt_pk(hv[6], hv[7]);
                u32x4 lw; lw.x = cvt_pk(hv[0] - bflo(hw.x), hv[1] - bfhi(hw.x)); lw.y = cvt_pk(hv[2] - bflo(hw.y), hv[3] - bfhi(hw.y));
                lw.z = cvt_pk(hv[4] - bflo(hw.z), hv[5] - bfhi(hw.z)); lw.w = cvt_pk(hv[6] - bflo(hw.w), hv[7] - bfhi(hw.w));
                const bf16x8 hf = *reinterpret_cast<bf16x8*>(&hw), lf = *reinterpret_cast<bf16x8*>(&lw);
#pragma unroll
                for (int et = 0; et < 4; ++et) {
                    acc[mt][et] = __builtin_amdgcn_mfma_f32_16x16x32_bf16(hf, whi[et], acc[mt][et], 0, 0, 0);
                    acc[mt][et] = __builtin_amdgcn_mfma_f32_16x16x32_bf16(lf, whi[et], acc[mt][et], 0, 0, 0);
                    acc[mt][et] = __builtin_amdgcn_mfma_f32_16x16x32_bf16(hf, wlo[et], acc[mt][et], 0, 0, 0); }
            }
        }
#pragma unroll
        for (int mt = 0; mt < 2; ++mt)
#pragma unroll
            for (int et = 0; et < 4; ++et)
#pragma unroll
                for (int i = 0; i < 4; ++i) plog[(wid * 32 + 16 * mt + 4 * g + i) * 64 + 16 * et + lq] = acc[mt][et][i];
        __syncthreads();
        float tot[4];
#pragma unroll
        for (int j = 0; j < 4; ++j) { const int idx = (wid * 64 + lane) * 4 + j; float sm = 0.f;
#pragma unroll
            for (int w = 0; w < 8; ++w) sm += plog[w * 2048 + idx];
            tot[j] = sm; }
        __syncthreads();
#pragma unroll
        for (int j = 0; j < 4; ++j) plog[(wid * 64 + lane) * 4 + j] = tot[j];
        __syncthreads();
        {
            float s4[4], cand4[4], w4[4]; int myk4[4];
#pragma unroll
            for (int rr = 0; rr < 4; ++rr) {
                const float logit = plog[(wid * 4 + rr) * 64 + lane];
                const float sg = 1.0f / (1.0f + expf(-logit)), bsd = sg + bias;
                float m1 = bsd; m1 = fmaxf(m1, __shfl_xor(m1, 1)); m1 = fmaxf(m1, __shfl_xor(m1, 2)); m1 = fmaxf(m1, __shfl_xor(m1, 4));
                const unsigned long long bal = __ballot(bsd == m1); const int gbase = lane & ~7; const unsigned gb = (unsigned)(bal >> gbase) & 0xffu; const int first = gbase + __ffs(gb) - 1;
                float m2 = (lane == first) ? -INFINITY : bsd; m2 = fmaxf(m2, __shfl_xor(m2, 1)); m2 = fmaxf(m2, __shfl_xor(m2, 2)); m2 = fmaxf(m2, __shfl_xor(m2, 4));
                const float gs = m1 + m2; int rank = 0;
#pragma unroll
                for (int j = 0; j < 8; ++j) { const float gj = __shfl(gs, 8 * j); rank += (gj > gs || (gj == gs && j < (lane >> 3))) ? 1 : 0; }
                s4[rr] = sg; cand4[rr] = rank < 4 ? bsd : -INFINITY; myk4[rr] = -1; }
#pragma unroll
            for (int k = 0; k < 8; ++k)
#pragma unroll
                for (int rr = 0; rr < 4; ++rr) { float mm = cand4[rr];
#pragma unroll
                    for (int o = 1; o < 64; o <<= 1) mm = fmaxf(mm, __shfl_xor(mm, o));
                    const unsigned long long bb = __ballot(cand4[rr] == mm); const int win = __ffsll((long long)bb) - 1;
                    if (lane == win) { myk4[rr] = k; cand4[rr] = -INFINITY; } }
#pragma unroll
            for (int rr = 0; rr < 4; ++rr) { const float wsum = wave_sum(myk4[rr] >= 0 ? s4[rr] : 0.f); w4[rr] = s4[rr] / wsum * 2.5f; }
            unsigned pos4[4];
#pragma unroll
            for (int rr = 0; rr < 4; ++rr) pos4[rr] = myk4[rr] >= 0 ? atomicAdd(cnt + lane * 64, 1u) : 0u;
#pragma unroll
            for (int rr = 0; rr < 4; ++rr) if (myk4[rr] >= 0) { const int rloc = wid * 4 + rr, aid = (row0 + rloc) * 8 + myk4[rr];
                list[(size_t)lane * TA + pos4[rr]] = row0 + rloc; sloti[aid] = (lane << 20) | (int)pos4[rr]; wts[aid] = w4[rr]; }
        }
    }
}
__device__ __forceinline__ void combine_rows(int nrows, bf16_t* __restrict__ x1, const unsigned char* __restrict__ Y, const float* __restrict__ wts, const int* __restrict__ sloti, const int* tstart, const float* __restrict__ mods_l,
                                             const float* __restrict__ gain_n, const float* __restrict__ mods_n, unsigned char* __restrict__ H, float* __restrict__ outp, int gw, int NGW, int lane) {
    for (int r = gw; r < nrows; r += NGW) {
        const int rt = r < TL ? (r >> 12) : 4;
        float acc[4][8];
#pragma unroll
        for (int j = 0; j < 4; ++j)
#pragma unroll
            for (int e = 0; e < 8; ++e) acc[j][e] = 0.f;
        int myrow; float myw;
        { const int kq = lane & 7; const int info = sloti[(size_t)r * 8 + kq]; myrow = tstart[info >> 20] * 256 + (info & 0xfffff); myw = wts[(size_t)r * 8 + kq]; }
#pragma unroll 3
        for (int k = 0; k < 9; ++k) { const size_t srow = k < 8 ? (size_t)__shfl(myrow, k) : (size_t)tstart[64] * 256 + r; const float w = k < 8 ? __shfl(myw, k) : 1.0f;
#pragma unroll
            for (int j = 0; j < 4; ++j) { const u32x2 v = *(const u32x2*)(Y + srow * D + 8 * lane + 512 * j);
                const f32x2 a0 = __builtin_amdgcn_cvt_pk_f32_fp8((int)v.x, false), a1 = __builtin_amdgcn_cvt_pk_f32_fp8((int)v.x, true), a2 = __builtin_amdgcn_cvt_pk_f32_fp8((int)v.y, false), a3 = __builtin_amdgcn_cvt_pk_f32_fp8((int)v.y, true);
                acc[j][0] += w * a0[0]; acc[j][1] += w * a0[1]; acc[j][2] += w * a1[0]; acc[j][3] += w * a1[1]; acc[j][4] += w * a2[0]; acc[j][5] += w * a2[1]; acc[j][6] += w * a3[0]; acc[j][7] += w * a3[1]; } }
        float ss = 0.f; const float* mp = mods_l + (size_t)rt * MODW + 5 * D;
#pragma unroll
        for (int j = 0; j < 4; ++j) { const int col = 8 * lane + 512 * j; bf16_t* xp = x1 + (size_t)r * D + col;
            const u32x4 xw = *(const u32x4*)xp; const float xv[8] = {bflo(xw.x), bfhi(xw.x), bflo(xw.y), bfhi(xw.y), bflo(xw.z), bfhi(xw.z), bflo(xw.w), bfhi(xw.w)};
            const f32x4 g2a = *(const f32x4*)(mp + col), g2b = *(const f32x4*)(mp + col + 4);
#pragma unroll
            for (int e = 0; e < 8; ++e) { const float y = xv[e] + (e < 4 ? g2a[e & 3] : g2b[e & 3]) * acc[j][e]; acc[j][e] = y; ss += y * y; }
            if (!outp) { u32x4 o; o.x = cvt_pk(acc[j][0], acc[j][1]); o.y = cvt_pk(acc[j][2], acc[j][3]); o.z = cvt_pk(acc[j][4], acc[j][5]); o.w = cvt_pk(acc[j][6], acc[j][7]); *(u32x4*)xp = o; } }
        const float rstd = rsqrtf(wave_sum(ss) * (1.0f / D) + EPS);
        if (outp) {
#pragma unroll
            for (int j = 0; j < 4; ++j)
#pragma unroll
                for (int q = 0; q < 2; ++q) { const int col = 8 * lane + 512 * j + 4 * q; const f32x4 gg = *(const f32x4*)(gain_n + col); f32x4 y;
#pragma unroll
                    for (int e = 0; e < 4; ++e) y[e] = acc[j][4 * q + e] * rstd * gg[e];
                    *(f32x4*)(outp + (size_t)r * D + col) = y; }
        } else {
            const float* mn = mods_n + (size_t)rt * MODW;
#pragma unroll
            for (int j = 0; j < 4; ++j) { const int col = 8 * lane + 512 * j; float y[8];
#pragma unroll
                for (int q = 0; q < 2; ++q) { const f32x4 gg = *(const f32x4*)(gain_n + col + 4 * q), sc = *(const f32x4*)(mn + 1 * D + col + 4 * q), sh = *(const f32x4*)(mn + col + 4 * q);
#pragma unroll
                    for (int e = 0; e < 4; ++e) y[4 * q + e] = acc[j][4 * q + e] * rstd * gg[e] * (1.0f + sc[e]) + sh[e]; }
                int w0 = 0, w1 = 0; w0 = __builtin_amdgcn_cvt_pk_fp8_f32(y[0], y[1], w0, false); w0 = __builtin_amdgcn_cvt_pk_fp8_f32(y[2], y[3], w0, true); w1 = __builtin_amdgcn_cvt_pk_fp8_f32(y[4], y[5], w1, false); w1 = __builtin_amdgcn_cvt_pk_fp8_f32(y[6], y[7], w1, true);
                u32x2 w; w.x = (unsigned)w0; w.y = (unsigned)w1; *(u32x2*)(H + (size_t)r * D + col) = w; }
        }
    }
}
__device__ __forceinline__ void rope_norm32(const bf16_t* __restrict__ src, unsigned char* __restrict__ dst8, int krow, const float* __restrict__ gn, const float* __restrict__ tab, int lane4, bool rope, int posr, int posc) {
    u32x4 w[4]; float x[32]; float ss = 0.f;
#pragma unroll
    for (int j = 0; j < 4; ++j) { w[j] = *(const u32x4*)(src + 8 * j);
        x[8 * j] = bflo(w[j].x); x[8 * j + 1] = bfhi(w[j].x); x[8 * j + 2] = bflo(w[j].y); x[8 * j + 3] = bfhi(w[j].y); x[8 * j + 4] = bflo(w[j].z); x[8 * j + 5] = bfhi(w[j].z); x[8 * j + 6] = bflo(w[j].w); x[8 * j + 7] = bfhi(w[j].w); }
#pragma unroll
    for (int e = 0; e < 32; ++e) ss += x[e] * x[e];
    ss += __shfl_xor(ss, 1); ss += __shfl_xor(ss, 2);
    const float rstd = rsqrtf(ss * (1.0f / 128.0f) + EPS);
    const int p0 = lane4 * 32, hf = p0 >> 6; const int pos = hf ? posc : posr;
#pragma unroll
    for (int e = 0; e < 32; e += 2) { const int j = ((p0 + e) & 63) >> 1;
        const float y1 = x[e] * rstd * gn[64 * hf + j], y2 = x[e + 1] * rstd * gn[64 * hf + 32 + j];
        float c = 1.f, s = 0.f; if (rope) { c = tab[pos * 32 + j]; s = tab[2048 + pos * 32 + j]; }
        x[e] = y1 * c - y2 * s; x[e + 1] = y2 * c + y1 * s; }
#pragma unroll
    for (int j = 0; j < 4; ++j) { const int p = p0 + 8 * j, byte = ((p >> 3) & 1) * 64 + (p >> 4) * 8;
        int wa = 0, wb = 0; wa = __builtin_amdgcn_cvt_pk_fp8_f32(x[8 * j], x[8 * j + 1], wa, false); wa = __builtin_amdgcn_cvt_pk_fp8_f32(x[8 * j + 2], x[8 * j + 3], wa, true);
        wb = __builtin_amdgcn_cvt_pk_fp8_f32(x[8 * j + 4], x[8 * j + 5], wb, false); wb = __builtin_amdgcn_cvt_pk_fp8_f32(x[8 * j + 6], x[8 * j + 7], wb, true);
        u32x2 o; o.x = (unsigned)wa; o.y = (unsigned)wb; *(u32x2*)(dst8 + ga::k8_off(krow, byte >> 4) + (byte & 15)) = o; }
}
__device__ __forceinline__ void post_odd(const bf16_t* __restrict__ PO, const float* __restrict__ gk, const float* __restrict__ tab,
                                         unsigned char* __restrict__ K8, unsigned char* __restrict__ VT8, char* lds, int vcu, int G, int gw, int NGW, int tid, int lane) {
    const int l32 = lane & 31;
    for (int r = 2 * gw + (lane >> 5); r < TA; r += 2 * NGW) {
        const bool lat = r < TL; int b, kp, posr = 0, posc = 0;
        if (lat) { b = r >> 12; const int t = r & (SEQ - 1); kp = CTXL + t; posr = t >> 6; posc = t & 63; } else { b = (r - TL) >> 8; kp = (r - TL) & (CTXL - 1); }
        const bf16_t* pr = PO + (size_t)r * ODD_IN;
        if (l32 < 16) rope_norm32(pr + 2048 + 32 * l32, K8 + (size_t)(((b * 4 + (l32 >> 2)) * 68) + (kp >> 6)) * 8192, kp & 63, gk, tab, l32 & 3, lat, posr, posc);
    }
    for (int tl = vcu; tl < NBATCH * 4 * 68; tl += G) {
        const int t68 = tl % 68, kvh = (tl / 68) & 3, b = tl / (68 * 4);
        const int k = tid >> 3, c = (tid & 7) * 16, kp = 64 * t68 + k;
        const size_t row = kp < CTXL ? (size_t)(TL + b * CTXL + kp) : (size_t)(b * SEQ + kp - CTXL);
        const bf16_t* vp = PO + row * ODD_IN + 2560 + kvh * 128 + c;
        const u32x2 f0 = ga::k8pack(*(const bf16x8*)vp), f1 = ga::k8pack(*(const bf16x8*)(vp + 8));
        __syncthreads();
        const int pos = ga::vt_pos(k);
#pragma unroll
        for (int e = 0; e < 16; ++e) { const unsigned w = e < 4 ? f0.x : e < 8 ? f0.y : e < 12 ? f1.x : f1.y; lds[ga::vt_off(c + e, pos)] = (char)((w >> (8 * (e & 3))) & 0xff); }
        __syncthreads();
        *(u32x4*)(VT8 + (size_t)tl * 8192 + tid * 16) = *(const u32x4*)(lds + tid * 16);
    }
}

__device__ __forceinline__ int dest_row(int n, int map) {
    if (map == 0) return n;
    if (map == 1) return (n >> 7) * 256 + (n & 127);
    if (map == 2) return (n >> 7) * 256 + 128 + (n & 127);
    if (n >= 2560) return n;
    const int head = n >> 7, i = n & 127, hf = i >> 6, ii = i & 63, part = ii >> 5, j = ii & 31;
    return head * 128 + hf * 64 + 2 * j + part;
}
struct TItem { const float* src; unsigned char* dst; int ldw, K, map, fp8; float scale; };
__device__ __forceinline__ void titem_load(const TItem& t, f32x4 (&v)[8], int lane) {
#pragma unroll
    for (int i = 0; i < 8; ++i) v[i] = __builtin_nontemporal_load((const f32x4*)(t.src + (size_t)(8 * (lane >> 3) + i) * t.ldw + 4 * (lane & 7)));
}
__device__ __forceinline__ void titem_store(const TItem& t, const f32x4 (&v)[8], int n0, int lane) {
    const int kq = 8 * (lane >> 3);
#pragma unroll
    for (int e = 0; e < 4; ++e) { const size_t drow = (size_t)dest_row(n0 + 4 * (lane & 7) + e, t.map);
        if (t.fp8) { int w0 = 0, w1 = 0;
            w0 = __builtin_amdgcn_cvt_pk_fp8_f32(v[0][e] * t.scale, v[1][e] * t.scale, w0, false); w0 = __builtin_amdgcn_cvt_pk_fp8_f32(v[2][e] * t.scale, v[3][e] * t.scale, w0, true);
            w1 = __builtin_amdgcn_cvt_pk_fp8_f32(v[4][e] * t.scale, v[5][e] * t.scale, w1, false); w1 = __builtin_amdgcn_cvt_pk_fp8_f32(v[6][e] * t.scale, v[7][e] * t.scale, w1, true);
            u32x2 o; o.x = (unsigned)w0; o.y = (unsigned)w1; *(u32x2*)(t.dst + drow * t.K + kq) = o;
        } else { u32x4 o; o.x = cvt_pk(v[0][e], v[1][e]); o.y = cvt_pk(v[2][e], v[3][e]); o.z = cvt_pk(v[4][e], v[5][e]); o.w = cvt_pk(v[6][e], v[7][e]); *(u32x4*)(t.dst + (drow * t.K + kq) * 2) = o; }
    }
}

struct Args { const float* in[26]; float* out; unsigned char* ws; int ph_lo, ph_hi; };
constexpr int NPHASE = 19;
#ifndef PHMASK
#define PHMASK 0xFFFFFFFFu
#endif
#define SITE(n) ((PHMASK >> (n)) & 1u)
__device__ __forceinline__ unsigned char* opq(unsigned char* p) { asm volatile("" : "+s"(p)); return p; }
__device__ __forceinline__ const float* opq(const float* p) { asm volatile("" : "+s"(p)); return p; }
__device__ __forceinline__ int opqi(int v) { asm volatile("" : "+s"(v)); return v; }
#define CAS __attribute__((address_space(4)))
__device__ __forceinline__ const CAS unsigned char* kargs() { const CAS unsigned char* p = (const CAS unsigned char*)__builtin_amdgcn_kernarg_segment_ptr(); asm volatile("" : "+s"(p)); return p; }
static_assert(sizeof(Args) == 232 && offsetof(Args, out) == 208 && offsetof(Args, ws) == 216 && offsetof(Args, ph_lo) == 224, "Args layout");
#define INP(k) (*(const float* const CAS*)(kargs() + 8 * (k)))
#define OUTP() (*(float* const CAS*)(kargs() + 208))
#define WSP(T, off) ((T*)(*(unsigned char* const CAS*)(kargs() + 216) + (off)))
#define PH_LO() (*(const int CAS*)(kargs() + 224))
#define PH_HI() (*(const int CAS*)(kargs() + 228))
#define IN(k) (PH_LO() <= (k) && (k) < PH_HI())

constexpr int T_ND = 13568, T_NX1 = 195 * 512;
#define TDESC(it_, t_, n0_) do { const int it__ = (it_); int kb_, nb_; \
        if (it__ < 6400) { kb_ = it__ / 200; nb_ = it__ % 200; t_.src = INP(8); t_.ldw = EVEN_IN; t_.K = D; t_.dst = WSP(unsigned char, WS_WINE); t_.map = 0; t_.fp8 = 1; t_.scale = 64.f; } \
        else if (it__ < 8448) { const int r_ = it__ - 6400; kb_ = r_ / 64; nb_ = r_ % 64; t_.src = INP(9); t_.ldw = D; t_.K = D; t_.dst = WSP(unsigned char, WS_WOUTE); t_.map = 0; t_.fp8 = 1; t_.scale = 64.f; } \
        else if (it__ < 11520) { const int r_ = it__ - 8448; kb_ = r_ / 96; nb_ = r_ % 96; t_.src = INP(13); t_.ldw = ODD_IN; t_.K = D; t_.dst = WSP(unsigned char, WS_WINO); t_.map = 3; t_.fp8 = 1; t_.scale = 64.f; } \
        else if (it__ < T_ND) { const int r_ = it__ - 11520; kb_ = r_ / 64; nb_ = r_ % 64; t_.src = INP(14); t_.ldw = D; t_.K = D; t_.dst = WSP(unsigned char, WS_WOUTO); t_.map = 0; t_.fp8 = 1; t_.scale = 64.f; } \
        else { const int r_ = it__ - T_ND, qq_ = r_ >> 9, w_ = r_ & 511, l_ = qq_ / 195, rem_ = qq_ % 195, e_ = rem_ / 3, mat_ = rem_ % 3; t_.fp8 = 1; \
            if (mat_ < 2) { kb_ = w_ >> 4; nb_ = w_ & 15; t_.src = e_ < 64 ? (mat_ == 0 ? INP(19) : INP(20)) + ((size_t)(l_ * 64 + e_)) * D * DEXP : (mat_ == 0 ? INP(22) : INP(23)) + (size_t)l_ * D * DEXP; \
                t_.ldw = DEXP; t_.K = D; t_.dst = WSP(unsigned char, WS_WGU) + ((size_t)(l_ * 65 + e_)) * 1024 * D; t_.map = 1 + mat_; t_.scale = 64.f; } \
            else { kb_ = w_ >> 6; nb_ = w_ & 63; t_.src = e_ < 64 ? INP(21) + ((size_t)(l_ * 64 + e_)) * DEXP * D : INP(24) + (size_t)l_ * DEXP * D; \
                t_.ldw = D; t_.K = DEXP; t_.dst = WSP(unsigned char, WS_WDN) + ((size_t)(l_ * 65 + e_)) * D * DEXP; t_.map = 0; t_.scale = 32.f; } } \
        t_.src += (size_t)(64 * kb_) * t_.ldw + 32 * nb_; t_.dst += (size_t)(64 * kb_) * (t_.fp8 ? 1 : 2); n0_ = 32 * nb_; } while (0)
struct Geo { int tid, lane, wid, G, bx, vcu, gw, NGW; };
__device__ __forceinline__ Geo geo(const int wid0) { Geo g; g.tid = opaque_tid(wid0); g.lane = g.tid & 63; g.wid = __builtin_amdgcn_readfirstlane(g.tid >> 6); g.G = gridDim.x; g.bx = blockIdx.x;
    g.vcu = (g.G % 8 == 0) ? (g.bx % 8) * (g.G / 8) + g.bx / 8 : g.bx; g.gw = g.vcu * NWAVES + g.wid; g.NGW = g.G * NWAVES; return g; }

__device__ __forceinline__ void phase_prologue(const Args& args, LAS unsigned char* ldsl, char* ldsg, const int wid0) {
    const Geo q = geo(wid0); const int tid = q.tid, lane = q.lane, wid = q.wid, G = q.G, bx = q.bx;
    for (int ait = bx; ait < 192; ait += G) {
        const float* c_in = INP(1); const float* cctx_in = INP(3); const float* w_ada = INP(4); const float* b_ada = INP(5); float* mods = WSP(float, WS_MODS);
        float* sl = (float*)ldsg; float* red = (float*)(ldsg + 40960);
        for (int i = tid; i < 5 * D; i += 512) { const int r = i >> 11, k = i & (D - 1); const float cv = r < 4 ? c_in[r * D + k] : cctx_in[k]; sl[i] = cv / (1.0f + expf(-cv)); }
        __syncthreads();
        const int l = ait / 96, n0 = (ait % 96) * 128, cg = tid & 31, kg = tid >> 5;
        f32x4 acc[5];
#pragma unroll
        for (int r = 0; r < 5; ++r) acc[r] = (f32x4){0.f, 0.f, 0.f, 0.f};
        const float* wp = w_ada + ((size_t)l * D + kg * 128) * MODW + n0 + 4 * cg;
#pragma unroll 8
        for (int k = 0; k < 128; ++k) { const f32x4 w = *(const f32x4*)(wp + (size_t)k * MODW);
#pragma unroll
            for (int r = 0; r < 5; ++r) acc[r] += w * sl[r * D + kg * 128 + k]; }
#pragma unroll
        for (int r = 0; r < 5; ++r) *(f32x4*)(red + (kg * 5 + r) * 128 + 4 * cg) = acc[r];
        __syncthreads();
        if (tid < 160) { const int r = tid >> 5; f32x4 sm = *(const f32x4*)(b_ada + (size_t)l * MODW + n0 + 4 * cg);
            for (int k2 = 0; k2 < 16; ++k2) sm += *(const f32x4*)(red + (k2 * 5 + r) * 128 + 4 * cg);
            *(f32x4*)(mods + ((size_t)l * 5 + r) * MODW + n0 + 4 * cg) = sm; }
        __syncthreads();
    }
    if (bx == G - 1) {
        float* tab = WSP(float, WS_TAB);
        for (int i = tid; i < 64 * 16; i += 512) { const int pos = i >> 4, j = i & 15; const float fr = expf(-9.210340371976184f * (float)j / 16.0f), a = (float)pos * fr; tab[i] = cosf(a); tab[1024 + i] = sinf(a); }
        for (int i = tid; i < 64 * 32; i += 512) { const int pos = i >> 5, j = i & 31; const float fr = expf(-9.210340371976184f * (float)j / 32.0f), a = (float)pos * fr; tab[2048 + i] = cosf(a); tab[4096 + i] = sinf(a); }
    }
    { const float* w_router = INP(17); bf16_t* wr_hi = WSP(bf16_t, WS_WR); bf16_t* wr_lo = wr_hi + 2 * 64 * 2048;
      for (int i = bx * 512 + tid; i < 2 * 64 * 2048; i += G * 512) {
        const int l = i >> 17, e = (i >> 11) & 63, k = i & 2047; const float w = w_router[((size_t)l * D + k) * 64 + e];
        const bf16_t hi16 = f2bf(w); wr_hi[i] = hi16; wr_lo[i] = f2bf(w - bf2f(hi16)); } }
    const int NIT = (PH_HI() - PH_LO() > 1) ? T_ND : T_ND + 2 * T_NX1;
    int it = q.gw;
    if (it < NIT) {
        TItem ta, tb; int na, nb2; f32x4 va[8], vb[8];
        TDESC(it, ta, na); titem_load(ta, va, lane);
        for (;;) {
            int nx = it + q.NGW;
            if (nx < NIT) { TDESC(nx, tb, nb2); titem_load(tb, vb, lane); }
            titem_store(ta, va, na, lane);
            if (nx >= NIT) break;
            it = nx; nx = it + q.NGW;
            if (nx < NIT) { TDESC(nx, ta, na); titem_load(ta, va, lane); }
            titem_store(tb, vb, nb2, lane);
            if (nx >= NIT) break;
            it = nx;
        }
    }
    __syncthreads();
}
template <int L> __device__ __forceinline__ void phase_inproj(const Args& args, LAS unsigned char* ldsl, const int wid0) {
    pg8::DenseSched S; S.init(TA, L == 0 ? EVEN_IN : ODD_IN, D / 2, gridDim.x, blockIdx.x, WSP(unsigned char, L == 0 ? WS_WINE : WS_WINO));
    pg8::EpiProj E{WSP(bf16_t, L == 0 ? WS_PE : WS_PO), L == 0 ? EVEN_IN : ODD_IN, L == 0 ? 20 : 0, L == 0 ? 24 : 0, L == 0 ? 24 : -1, WSP(float, WS_TAB)};
    pg8::gemm_phase<pg8::EpiProj, pg8::DenseSched, true, 127 - 6, true>(ldsl, (const char*)WSP(unsigned char, WS_H), D / 2, S, E, wid0);
}
template <int L> __device__ __forceinline__ void phase_outproj(const Args& args, LAS unsigned char* ldsl, const int wid0) {
    constexpr int T = L == 0 ? TA : TL;
    pg8::DenseSched S; S.init(T, D, D / 2, gridDim.x, blockIdx.x, WSP(unsigned char, L == 0 ? WS_WOUTE : WS_WOUTO));
    pg8::EpiOutRes<L != 0> E{INP(0), INP(2), WSP(bf16_t, WS_X1), WSP(float, WS_MODS) + (size_t)L * 5 * MODW + 2 * D};
    pg8::gemm_phase<pg8::EpiOutRes<L != 0>, pg8::DenseSched, true, 127 - 6, true>(ldsl, (const char*)WSP(unsigned char, WS_CAT), D / 2, S, E, wid0);
}
template <int L> __device__ __forceinline__ void phase_router(const Args& args, char* ldsg, const int wid0) {
    constexpr int T = L == 0 ? TA : TL; const Geo q = geo(wid0);
    bf16_t* wr_hi = WSP(bf16_t, WS_WR);
    norm2_router(T, WSP(bf16_t, WS_X1), INP(7) + (size_t)L * D, WSP(float, WS_MODS) + (size_t)L * 5 * MODW, WSP(unsigned char, WS_H8), wr_hi + (size_t)L * 64 * D, wr_hi + (size_t)(2 + L) * 64 * D, INP(18) + L * 64,
                 WSP(unsigned, WS_CTL) + CW_CNT + L * 64 * 64, WSP(int, WS_LIST), WSP(float, WS_WTS), WSP(int, WS_SLOTI), ldsg, q.vcu, q.G, q.wid, q.lane);
}
template <int L> __device__ __forceinline__ void moe_tables(const Args& args, LAS unsigned char* ldsl, int NT, int tid) {
    constexpr int T = L == 0 ? TA : TL;
    LAS int* ustart = (LAS int*)(ldsl + MISC_OFF + 64 * 4); LAS int* ecnt = (LAS int*)(ldsl + MISC_OFF + 192 * 4); LAS int* tstart = (LAS int*)(ldsl + MISC_OFF + 320 * 4);
    unsigned* cnt = WSP(unsigned, WS_CTL) + CW_CNT + L * 64 * 64;
    __syncthreads();
    if (tid < 65) ecnt[tid] = tid < 64 ? (int)__hip_atomic_load(cnt + tid * 64, __ATOMIC_RELAXED, __HIP_MEMORY_SCOPE_AGENT) : T;
    __syncthreads();
    if (tid == 0) { int su = 0, st = 0; for (int e = 0; e < 65; ++e) { ustart[e] = su; tstart[e] = st; const int nt = (ecnt[e] + 255) >> 8; su += nt * NT; st += nt; } ustart[65] = su; tstart[65] = st; }
    __syncthreads();
}
template <int L, int MODE> __device__ __forceinline__ void phase_moe(const Args& args, LAS unsigned char* ldsl, const int wid0) {
    constexpr int NT = MODE == 0 ? 4 : 8; const Geo q = geo(wid0);
    moe_tables<L>(args, ldsl, NT, q.tid);
    LAS int* ustart = (LAS int*)(ldsl + MISC_OFF + 64 * 4); LAS int* ecnt = (LAS int*)(ldsl + MISC_OFF + 192 * 4); LAS int* tstart = (LAS int*)(ldsl + MISC_OFF + 320 * 4);
    pg8::MoeSched S; S.ustart = ustart; S.ecnt = ecnt; S.tstart = tstart; S.total = ustart[65]; S.G = q.G; S.c = q.vcu; S.NT = NT; S.mode = MODE; S.list = WSP(int, WS_LIST);
    if constexpr (MODE == 0) { S.Bt = (const char*)(WSP(unsigned char, WS_WGU) + (size_t)L * 65 * 1024 * D); S.estepB = (size_t)1024 * D; S.tstepB = (size_t)256 * D;
        pg8::EpiGateUp E{WSP(unsigned char, WS_HID)};
        pg8::gemm_phase<pg8::EpiGateUp, pg8::MoeSched, true, 127 - 6, true>(ldsl, (const char*)WSP(unsigned char, WS_H8), D / 2, S, E, wid0);
    } else { S.Bt = (const char*)(WSP(unsigned char, WS_WDN) + (size_t)L * 65 * D * DEXP); S.estepB = (size_t)D * DEXP; S.tstepB = (size_t)256 * DEXP;
        pg8::EpiDown E{WSP(unsigned char, WS_Y)};
        pg8::gemm_phase<pg8::EpiDown, pg8::MoeSched, true, 127 - 5, true>(ldsl, (const char*)WSP(unsigned char, WS_HID), DEXP / 2, S, E, wid0);
    }
}
template <int L> __device__ __forceinline__ void phase_combine(const Args& args, LAS unsigned char* ldsl, char* ldsg, const int wid0) {
    constexpr int T = L == 0 ? TA : TL; const Geo q = geo(wid0);
    moe_tables<L>(args, ldsl, 1, q.tid);
    float* mods = WSP(float, WS_MODS);
    combine_rows(T, WSP(bf16_t, WS_X1), WSP(unsigned char, WS_Y), WSP(float, WS_WTS), WSP(int, WS_SLOTI), (const int*)(ldsg + MISC_OFF + 320 * 4), mods + (size_t)L * 5 * MODW, L == 0 ? INP(6) + D : INP(25), mods + (size_t)5 * MODW, WSP(unsigned char, WS_H), L == 0 ? nullptr : OUTP(), q.gw, q.NGW, q.lane);
}

constexpr unsigned Q_A = 2 * 65 * 512 / 16, Q_B = 3 * 65 * 512 / 16, Q_ALL = 2 * 3 * 65 * 512 / 16;
__device__ __forceinline__ int queue_item(unsigned p) {
    if (p < 2u * 65u * 512u) { const unsigned qa = p >> 9; return T_ND + (int)((((qa >> 1) * 3u + (qa & 1u)) << 9) | (p & 511u)); }
    if (p < 3u * 65u * 512u) { const unsigned pb = p - 2u * 65u * 512u; return T_ND + (int)((((pb >> 9) * 3u + 2u) << 9) | (pb & 511u)); }
    return T_ND + (int)p;
}
__device__ __forceinline__ void steal_convert(unsigned* ctl, int seam, unsigned drain_to, volatile LAS unsigned* MISC, const int wid0) {
    const int tid = opaque_tid(wid0), lane = tid & 63, wid = __builtin_amdgcn_readfirstlane(tid >> 6);
    if (MISC[18] != 0u) return;
    if (tid == 0) __hip_atomic_fetch_add(ctl + CW_ARR + seam * 64, 1u, __ATOMIC_RELAXED, __HIP_MEMORY_SCOPE_AGENT);
    unsigned last = 0u;
#define STEAL_CLAIM(stop_, c_) do { __syncthreads(); if (tid == 0) { unsigned st_ = 0u, cc_ = 0u; \
        const bool all_here_ = __hip_atomic_load(ctl + CW_ARR + seam * 64, __ATOMIC_RELAXED, __HIP_MEMORY_SCOPE_AGENT) >= gridDim.x; \
        if (all_here_ && last >= drain_to) st_ = 1u; \
        else { cc_ = __hip_atomic_fetch_add(ctl + CW_Q, 1u, __ATOMIC_RELAXED, __HIP_MEMORY_SCOPE_AGENT); if (cc_ >= Q_ALL) { st_ = 1u; MISC[18] = 1u; } } \
        MISC[16] = st_; MISC[17] = cc_; } \
        __syncthreads(); stop_ = MISC[16]; c_ = MISC[17]; if (!stop_) last = c_ + 1u; } while (0)
#define STEAL_LOAD(c_, t0_, t1_, n0_, n1_, v0_, v1_) do { TDESC(queue_item((c_) * 16u + (unsigned)wid), t0_, n0_); titem_load(t0_, v0_, lane); TDESC(queue_item((c_) * 16u + 8u + (unsigned)wid), t1_, n1_); titem_load(t1_, v1_, lane); } while (0)
    TItem ta0, ta1, tb0, tb1; int na0, na1, nb0, nb1; f32x4 va0[8], va1[8], vb0[8], vb1[8];
    unsigned stop, c;
    STEAL_CLAIM(stop, c);
    if (stop) return;
    STEAL_LOAD(c, ta0, ta1, na0, na1, va0, va1);
    for (;;) {
        STEAL_CLAIM(stop, c);
        if (!stop) STEAL_LOAD(c, tb0, tb1, nb0, nb1, vb0, vb1);
        titem_store(ta0, va0, na0, lane); titem_store(ta1, va1, na1, lane);
        if (stop) break;
        STEAL_CLAIM(stop, c);
        if (!stop) STEAL_LOAD(c, ta0, ta1, na0, na1, va0, va1);
        titem_store(tb0, vb0, nb0, lane); titem_store(tb1, vb1, nb1, lane);
        if (stop) break;
    }
#undef STEAL_CLAIM
#undef STEAL_LOAD
}

__global__ void __launch_bounds__(NWAVES * 64, 2) mega(Args args) {
    extern __shared__ __attribute__((aligned(16))) unsigned char lds_raw[];
    LAS unsigned char* ldsl = (LAS unsigned char*)lds_raw;
    char* ldsg = (char*)lds_raw;
    volatile LAS unsigned* MISC = (volatile LAS unsigned*)(ldsl + MISC_OFF);
    const int wid0 = __builtin_amdgcn_readfirstlane(threadIdx.x >> 6);
    for (int u = threadIdx.x; u < (LDS_BYTES - MISC_OFF) / 4; u += NWAVES * 64) MISC[u] = 0u;
    __syncthreads();
    XcdBarrier bar; bar.bar = WSP(unsigned, WS_CTL) + CW_BAR; bar.x = 0; bar.st = nullptr; bar.wid0 = wid0;
    if (PH_HI() - PH_LO() > 1) bar = xcd_barrier_post(WSP(unsigned, WS_CTL) + CW_BAR, MISC + 8, wid0);
#define SEAM(k) do { if (IN(k) && IN((k) + 1)) { if ((k) <= 15) steal_convert(WSP(unsigned, WS_CTL), (k), (k) == 7 ? Q_A : (k) == 8 ? Q_B : (k) == 15 ? Q_ALL : 0u, MISC, wid0); xcd_barrier(bar); } } while (0)

    if (SITE(0) && IN(0)) REP(0) phase_prologue(args, ldsl, ldsg, wid0);
    SEAM(0);
    if (SITE(1) && IN(1)) { const Geo q = geo(wid0); norm_mod_rows(INP(0), INP(2), TA, INP(6), WSP(float, WS_MODS), 0, 1, WSP(unsigned char, WS_H), q.gw, q.NGW, q.lane); }
    SEAM(1);
    if (SITE(2) && IN(2)) REP(2) phase_inproj<0>(args, ldsl, wid0);
    SEAM(2);
    if (SITE(3) && IN(3)) REP(3) {
        const Geo q = geo(wid0); const bf16_t* PE = WSP(bf16_t, WS_PE); unsigned char* CAT = WSP(unsigned char, WS_CAT);
        { const float* lbl = INP(10); bf16_t* UB = WSP(bf16_t, WS_U); float* DEC = WSP(float, WS_DEC);
          for (int it = q.vcu; it < NBATCH * 8 * NCHK; it += q.G) { const int ci = it % NCHK, h = (it / NCHK) & 7, b = it / (NCHK * 8); hgrn_a_item(ldsg, PE, lbl, UB, DEC, b, h, ci, wid0); } }
        __syncthreads();
        { const float* sink = INP(12);
          for (int it = (q.vcu + q.G / 2) % q.G; it < 544; it += q.G) {
            if (it < 512) win_attn_item2(ldsg, PE, CAT, sink, it >> 7, (it >> 6) & 1, it & 63, false, wid0);
            else { const int r = it - 512; win_attn_item2(ldsg, PE, CAT, sink, r >> 3, (r >> 2) & 1, r & 3, true, wid0); } } }
    }
    SEAM(3);
    if (SITE(4) && IN(4)) REP(4) hgrn_b_phase(WSP(bf16_t, WS_U), WSP(float, WS_DEC), WSP(bf16_t, WS_S), wid0);
    SEAM(4);
    if (SITE(5) && IN(5)) REP(5) { const Geo q = geo(wid0); const bf16_t* PE = WSP(bf16_t, WS_PE); unsigned char* CAT = WSP(unsigned char, WS_CAT); const float* lbl = INP(10); const bf16_t* SB = WSP(bf16_t, WS_S); const float* gh = INP(11);
        for (int it = q.vcu; it < NBATCH * 8 * NCHK; it += q.G) { const int ci = it % NCHK, h = (it / NCHK) & 7, b = it / (NCHK * 8); hgrn_c_item(ldsg, PE, lbl, SB, gh, CAT, b, h, ci, wid0); } }
    SEAM(5);
    if (SITE(8) && IN(6)) REP(6) phase_outproj<0>(args, ldsl, wid0);
    SEAM(6);
    if (SITE(9) && IN(7)) phase_router<0>(args, ldsg, wid0);
    SEAM(7);
    if (SITE(10) && IN(8)) REP(8) phase_moe<0, 0>(args, ldsl, wid0);
    SEAM(8);
    if (SITE(11) && IN(9)) REP(9) phase_moe<0, 1>(args, ldsl, wid0);
    SEAM(9);
    if (SITE(12) && IN(10)) phase_combine<0>(args, ldsl, ldsg, wid0);
    SEAM(10);
    if (SITE(2) && IN(11)) REP(11) phase_inproj<1>(args, ldsl, wid0);
    SEAM(11);
    if (SITE(6) && IN(12)) REP(12) { const Geo q = geo(wid0); post_odd(WSP(bf16_t, WS_PO), INP(16), WSP(float, WS_TAB) + 2048, WSP(unsigned char, WS_KALL), WSP(unsigned char, WS_VALL), ldsg, q.vcu, q.G, q.gw, q.NGW, q.tid, q.lane); }
    SEAM(12);
    if (SITE(7) && IN(13)) REP(13) { const Geo q = geo(wid0); const bf16_t* PO = WSP(bf16_t, WS_PO); const float* gqn = INP(15); const float* tabo = WSP(float, WS_TAB) + 2048; const unsigned char* KALL = WSP(unsigned char, WS_KALL); const unsigned char* VALL = WSP(unsigned char, WS_VALL); unsigned char* CAT = WSP(unsigned char, WS_CAT);
        for (int it = q.vcu; it < 1024; it += q.G) { const int gq = it & 3, qb = (it >> 2) & 15, kvh = (it >> 6) & 3, b = it >> 8, h = kvh * 4 + gq;
            ga::attn_dense_body(PO + ((size_t)(b * SEQ + qb * 256)) * ODD_IN + h * 128, gqn, tabo, qb * 256, KALL + (size_t)((b * 4 + kvh) * 68) * 8192, VALL + (size_t)((b * 4 + kvh) * 68) * 8192,
                                CAT + ((size_t)(b * SEQ + qb * 256)) * D + h * 128, CTXL + SEQ, ldsg, wid0); } }
    SEAM(13);
    if (SITE(8) && IN(14)) phase_outproj<1>(args, ldsl, wid0);
    SEAM(14);
    if (SITE(9) && IN(15)) phase_router<1>(args, ldsg, wid0);
    SEAM(15);
    if (SITE(10) && IN(16)) REP(16) phase_moe<1, 0>(args, ldsl, wid0);
    SEAM(16);
    if (SITE(11) && IN(17)) REP(17) phase_moe<1, 1>(args, ldsl, wid0);
    SEAM(17);
    if (SITE(12) && IN(18)) phase_combine<1>(args, ldsl, ldsg, wid0);
    if (IN(21)) {
        const Geo q = geo(wid0); const bf16_t* buf = WSP(bf16_t, DBG_BUF_OFF); float* outp = OUTP();
        for (size_t i = (size_t)q.bx * 512 + q.tid; i < (size_t)TL * D; i += (size_t)q.G * 512) { const size_t r = i / D, c = i % D; float v = (c < DBG_BUF_NC && r < DBG_NR) ? (DBG_F32 ? ((const float*)buf)[r * DBG_BUF_LD + DBG_BUF_COL0 + c] : bf2f(buf[r * DBG_BUF_LD + DBG_BUF_COL0 + c])) : 0.f; if (DBG_NANCHK == 1) v = (v == v && fabsf(v) < 1e30f) ? 0.f : 1.f; if (DBG_NANCHK == 2) v = (v == v) ? fminf(fmaxf(v, -1e3f), 1e3f) : 1e3f; outp[i] = v; }
    }
    if (IN(19) || IN(20)) {
        const Geo q = geo(wid0); const float* src = INP(0); const float* gf = INP(25); float* outp = OUTP();
        for (int r = q.gw; r < TL; r += q.NGW) { f32x4 v[8]; float ss = 0.f;
#pragma unroll
            for (int j = 0; j < 8; ++j) { v[j] = *(const f32x4*)(src + (size_t)r * D + 4 * q.lane + 256 * j); ss += (v[j][0] * v[j][0] + v[j][1] * v[j][1]) + (v[j][2] * v[j][2] + v[j][3] * v[j][3]); }
            const float rstd = rsqrtf(wave_sum(ss) * (1.0f / D) + EPS);
#pragma unroll
            for (int j = 0; j < 8; ++j) *(f32x4*)(outp + (size_t)r * D + 4 * q.lane + 256 * j) = v[j] * rstd * *(const f32x4*)(gf + 4 * q.lane + 256 * j); }
    }
#undef SEAM
}

extern "C" void kernel_launch(void* const* d_in, const int* in_sizes, int n_in, void* d_out, int out_size, void* d_ws, size_t ws_size, hipStream_t stream) {
    static int grid = 0;
    if (grid == 0) {
        if (n_in != 26 || in_sizes[0] != TL * D || out_size != TL * D || ws_size < WS_END) { fprintf(stderr, "kernel_launch: unexpected shapes (n_in %d, in0 %d, out %d, ws %zu < %zu)\n", n_in, n_in > 0 ? in_sizes[0] : -1, out_size, ws_size, (size_t)WS_END); grid = -1; return; }
        int dev = 0, cus = 0, per_cu = 0;
        if (hipGetDevice(&dev) != hipSuccess || hipDeviceGetAttribute(&cus, hipDeviceAttributeMultiprocessorCount, dev) != hipSuccess) { grid = -1; return; }
        if (hipFuncSetAttribute((const void*)mega, hipFuncAttributeMaxDynamicSharedMemorySize, LDS_BYTES) != hipSuccess) { fprintf(stderr, "kernel_launch: hipFuncSetAttribute failed\n"); grid = -1; return; }
        if (hipOccupancyMaxActiveBlocksPerMultiprocessor(&per_cu, (const void*)mega, NWAVES * 64, LDS_BYTES) != hipSuccess || per_cu < 1) fprintf(stderr, "kernel_launch: occupancy query reports %d\n", per_cu);
        (void)hipGetLastError();
        grid = cus;
    }
    if (grid < 0) return;
    if (hipMemsetAsync((char*)d_ws + WS_CTL, 0, CTL_ZERO_BYTES, stream) != hipSuccess) return;
    Args a{};
    for (int i = 0; i < 26; ++i) a.in[i] = (const float*)d_in[i];
    a.out = (float*)d_out; a.ws = (unsigned char*)d_ws;
#if N_LAUNCH_MODE == 1
    a.ph_lo = 0; a.ph_hi = NPHASE;
    hipLaunchKernelGGL(mega, dim3(grid), dim3(NWAVES * 64), LDS_BYTES, stream, a);
#else
    for (int p = 0; p < DBG_NPH; ++p) { a.ph_lo = p; a.ph_hi = p + 1; hipLaunchKernelGGL(mega, dim3(grid), dim3(NWAVES * 64), LDS_BYTES, stream, a); }
    if (DBG_FIN) { a.ph_lo = DBG_FIN; a.ph_hi = DBG_FIN + 1; hipLaunchKernelGGL(mega, dim3(grid), dim3(NWAVES * 64), LDS_BYTES, stream, a); }
#endif
    const hipError_t le = hipPeekAtLastError();
    if (le != hipSuccess) fprintf(stderr, "kernel_launch: launch failed: %s\n", hipGetErrorName(le));
}
```

```cpp
#include <hip/hip_runtime.h>
#include <cstdio>
#include <cstdint>
#include <cstddef>

#ifndef N_LAUNCH_MODE
#define N_LAUNCH_MODE 1
#endif
#define REPEAT_MASK 0u
#define REP(k) for (int rep_ = 0; rep_ < 1 + (int)((REPEAT_MASK >> (k)) & 1u); ++rep_)
#define DBG_NPH 19
#define DBG_BUF_OFF WS_U
#define DBG_BUF_LD 2048
#define DBG_BUF_COL0 0
#define DBG_BUF_NC 2048
#define DBG_NANCHK 2
#define DBG_F32 0
#define DBG_NR 16384
#define DBG_FIN 0

#define LAS __attribute__((address_space(3)))
#define GAS __attribute__((address_space(1)))
typedef unsigned short bf16_t;
typedef short bf16x8 __attribute__((ext_vector_type(8)));
typedef short s16x4 __attribute__((ext_vector_type(4)));
typedef float f32x4 __attribute__((ext_vector_type(4)));
typedef float f32x2 __attribute__((ext_vector_type(2)));
typedef unsigned u32x4 __attribute__((ext_vector_type(4)));
typedef unsigned u32x2 __attribute__((ext_vector_type(2)));

constexpr int D = 2048, NBATCH = 4, SEQ = 4096, CTXL = 256;
constexpr int TL = NBATCH * SEQ, TC = NBATCH * CTXL, TA = TL + TC;
constexpr int EVEN_IN = 6400, ODD_IN = 3072;
constexpr int NE = 64, DEXP = 512;
constexpr int NCHK = 68;
constexpr float EPS = 1e-6f;
constexpr int MODW = 6 * D;

constexpr size_t MiB = 1u << 20;
constexpr size_t WS_CTL = 0, CTL_ZERO_BYTES = 1 * MiB;
constexpr size_t WS_MODS = 1 * MiB;
constexpr size_t WS_TAB = 2 * MiB;
constexpr size_t WS_WR = 3 * MiB;
constexpr size_t WS_WINE = 4 * MiB;
constexpr size_t WS_WOUTE = 29 * MiB;
constexpr size_t WS_WINO = 37 * MiB;
constexpr size_t WS_WOUTO = 49 * MiB;
constexpr size_t WS_WGU = 57 * MiB;
constexpr size_t WS_WDN = 577 * MiB;
constexpr size_t WS_X1 = 837 * MiB;
constexpr size_t WS_H = 973 * MiB;
constexpr size_t WS_CAT = 1041 * MiB;
constexpr size_t WS_LIST = 1109 * MiB;
constexpr size_t WS_WTS = 1113 * MiB + 512 * 1024;
constexpr size_t WS_SLOTI = WS_WTS + (size_t)8 * TA * 4;
constexpr size_t WS_R = 1115 * MiB;
constexpr size_t WS_PE = WS_R, WS_U = WS_R + 213 * MiB, WS_S = WS_R + 349 * MiB, WS_DEC = WS_R + 485 * MiB;
constexpr size_t WS_PO = WS_R, WS_QN = WS_R + 102 * MiB, WS_KALL = WS_R + 166 * MiB, WS_VALL = WS_R + 183 * MiB;
constexpr int MAXTILES = 675;
constexpr size_t WS_HID = WS_R, WS_Y = WS_R + 85 * MiB, WS_H8 = WS_R + 760 * MiB;
constexpr size_t WS_END = WS_R + 794 * MiB;
static_assert((size_t)TA * EVEN_IN * 2 <= 213 * MiB && (size_t)NBATCH * 8 * 2 * NCHK * 128 * 128 * 2 <= 136 * MiB, "even map");
static_assert((size_t)MAXTILES * 256 * 512 <= 85 * MiB && (size_t)MAXTILES * 256 * 2048 * 2 <= 675 * MiB && (size_t)TA * 2048 <= 34 * MiB && (8 * TA + 64 * 255) / 256 + 68 <= MAXTILES, "moe map");
static_assert((size_t)TA * ODD_IN * 2 <= 102 * MiB && (size_t)TL * 2048 * 2 <= 64 * MiB && (size_t)NBATCH * 4352 * 512 * 2 <= 17 * MiB, "odd map");
static_assert(WS_SLOTI + (size_t)8 * TA * 4 <= WS_R && WS_LIST + (size_t)64 * TA * 4 <= WS_WTS, "list / wts / slot info");
constexpr int CW_BAR = 4096;
constexpr int CW_CNT = 16384;
constexpr int CW_Q = 32768;
constexpr int CW_ARR = 32768 + 64;

constexpr int LDS_BYTES = 155648;
constexpr int MISC_OFF = 153600;
constexpr int NWAVES = 8;

typedef __bf16 bf16v2 __attribute__((ext_vector_type(2)));
__device__ __forceinline__ unsigned cvt_pk(float lo, float hi) { f32x2 v = {lo, hi}; bf16v2 b = __builtin_convertvector(v, bf16v2); return __builtin_bit_cast(unsigned, b); }
__device__ __forceinline__ float bflo(unsigned u) { return __uint_as_float(u << 16); }
__device__ __forceinline__ float bfhi(unsigned u) { return __uint_as_float(u & 0xffff0000u); }
__device__ __forceinline__ float bf2f(bf16_t u) { return __uint_as_float(((unsigned)u) << 16); }
__device__ __forceinline__ bf16_t f2bf(float f) { return (bf16_t)(cvt_pk(f, 0.f) & 0xffffu); }
__device__ __forceinline__ unsigned char f2fp8(float f) { return (unsigned char)(__builtin_amdgcn_cvt_pk_fp8_f32(f, 0.f, 0, false) & 0xff); }
__device__ __forceinline__ float wave_sum(float v) {
#pragma unroll
    for (int o = 1; o < 64; o <<= 1) v += __shfl_xor(v, o);
    return v;
}
__device__ __forceinline__ float sigmoidf_(float x) { return __builtin_amdgcn_rcpf(1.0f + __builtin_amdgcn_exp2f(-1.4426950408889634f * x)); }
__device__ __forceinline__ float siluf_(float x) { return x * __builtin_amdgcn_rcpf(1.0f + __builtin_amdgcn_exp2f(-1.4426950408889634f * x)); }
__device__ __forceinline__ int opaque_tid(int wid0) { int t = wid0 * 64 + (int)__builtin_amdgcn_mbcnt_hi(~0u, __builtin_amdgcn_mbcnt_lo(~0u, 0u)); asm volatile("" : "+v"(t)); return t; }
#define LDS_WAIT() asm volatile("s_waitcnt lgkmcnt(0)" ::: "memory")
#define VM_WAIT() asm volatile("s_waitcnt vmcnt(0)" ::: "memory")

#define XB_TMO      128
#define XB_XCNT(j)  (256  + 64 * (j))
#define XB_XSUB(j)  (1280 + 64 * (j))
#define XB_XGEN(j)  (2304 + 64 * (j))
#define XB_TOP      3328
#define XB_TOPGEN   3392
#define XCD_BAR_WORDS 3456
#define XB_SPIN_CAP (1u << 18)
__device__ __forceinline__ unsigned xb_ld(unsigned* p)              { return __hip_atomic_load(p, __ATOMIC_RELAXED, __HIP_MEMORY_SCOPE_AGENT); }
__device__ __forceinline__ unsigned xb_add(unsigned* p, unsigned v) { return __hip_atomic_fetch_add(p, v, __ATOMIC_RELAXED, __HIP_MEMORY_SCOPE_AGENT); }
__device__ __forceinline__ unsigned xb_xcc_id() { return (unsigned)__builtin_amdgcn_s_getreg((3 << 11) | 20) & 0xFu; }
#define XB_SPIN(cond, bar) do { unsigned _sp = 0; while (cond) { __builtin_amdgcn_s_sleep(1); \
    if ((++_sp & 255u) == 0u) { if (xb_ld(&(bar)[XB_TMO])) break; if (_sp > XB_SPIN_CAP) { atomicAdd(&(bar)[XB_TMO], 1u); break; } } } } while (0)
struct XcdBarrier { unsigned* bar; unsigned x; volatile LAS unsigned* st; int wid0; };
__device__ __forceinline__ bool xb_leader(int wid0) { return wid0 == 0 && __builtin_amdgcn_mbcnt_hi(~0u, __builtin_amdgcn_mbcnt_lo(~0u, 0u)) == 0u; }
__device__ __forceinline__ XcdBarrier xcd_barrier_post(unsigned* bar, volatile LAS unsigned* st, int wid0) {
    XcdBarrier b; b.bar = bar; b.x = xb_xcc_id(); b.st = st; b.wid0 = wid0;
    if (xb_leader(wid0)) (void)xb_add(&bar[XB_XCNT(b.x)], 1u);
    return b;
}
__device__ __forceinline__ void xcd_barrier_complete(unsigned* bar, unsigned x, unsigned& nloc, unsigned& nx) {
    const unsigned G = gridDim.x * gridDim.y * gridDim.z;
    unsigned sum, cnt, mine, sp = 0u;
    for (;;) {
        sum = 0u; cnt = 0u; mine = 0u;
#pragma unroll
        for (unsigned j = 0; j < 16; ++j) { const unsigned c = xb_ld(&bar[XB_XCNT(j)]); sum += c; cnt += (c > 0u) ? 1u : 0u; mine = (j == x) ? c : mine; }
        if (sum == G) break;
        __builtin_amdgcn_s_sleep(1);
        if ((++sp & 255u) == 0u) { if (xb_ld(&bar[XB_TMO])) break; if (sp > XB_SPIN_CAP) { atomicAdd(&bar[XB_TMO], 1u); break; } }
    }
    nloc = mine > 0u ? mine : 1u; nx = cnt > 0u ? cnt : 1u;
}
__device__ __forceinline__ void xcd_barrier(const XcdBarrier& b) {
    asm volatile("s_waitcnt vmcnt(0)" ::: "memory");
    __syncthreads();
    if (xb_leader(b.wid0)) {
        unsigned* bar = b.bar;
        __builtin_amdgcn_s_waitcnt(0);
        unsigned nloc = b.st[0], nx = b.st[1];
        if (nloc == 0u) { xcd_barrier_complete(bar, b.x, nloc, nx); b.st[0] = nloc; b.st[1] = nx; }
        const unsigned old = xb_add(&bar[XB_XSUB(b.x)], 1u);
        const unsigned gen = old / nloc;
        if (old + 1u == (gen + 1u) * nloc) {
            __builtin_amdgcn_fence(__ATOMIC_RELEASE, "agent");
            asm volatile("s_waitcnt vmcnt(0)" ::: "memory");
            const unsigned og = xb_add(&bar[XB_TOP], 1u);
            const unsigned tg = og / nx;
            if (og + 1u == (tg + 1u) * nx) xb_add(&bar[XB_TOPGEN], 1u);
            else XB_SPIN(xb_ld(&bar[XB_TOPGEN]) == tg, bar);
            __builtin_amdgcn_fence(__ATOMIC_ACQUIRE, "agent");
            xb_add(&bar[XB_XGEN(b.x)], 1u);
            asm volatile("s_waitcnt vmcnt(0)" ::: "memory");
        } else {
            XB_SPIN(xb_ld(&bar[XB_XGEN(b.x)]) == gen, bar);
            __builtin_amdgcn_fence(__ATOMIC_ACQUIRE, "agent");
            asm volatile("s_waitcnt vmcnt(0)" ::: "memory");
        }
    }
    __syncthreads();
}

namespace pg8 {
constexpr int BM = 256, BK = 64, HALF = 128, HTB = HALF * BK * 2, STAGE_BYTES = 8 * HTB, NXCD = 8, WGM = 8;
__host__ __device__ __forceinline__ int lds_byte(int r, int c) { const int st = (r >> 4) * 2 + (c >> 5), rr = r & 15, cc = c & 31, ob = rr * 64 + cc * 2; return st * 1024 + (ob ^ (((ob >> 9) & 1) << 5)); }
__host__ __device__ __forceinline__ void stage_rc(int b, int& R, int& C) { const int st = b / 1024, sb = b % 1024, swz = sb ^ (((sb >> 9) & 1) << 5); R = (st >> 1) * 16 + swz / 64; C = (st & 1) * 32 + (swz % 64) / 2; }

__host__ __device__ __forceinline__ int perm32(int rho) { const int n = rho >> 4, i = rho & 15; return 8 * (i >> 2) + 4 * n + (i & 3); }
struct Unit { int pm, pn, e, cnt, tb; };

struct DenseSched {
    static constexpr bool DENSE = true;
    int nM, nN, nwg, G, c; unsigned rowbytes; const char* Bt; size_t tstepB;
    __device__ void init(int M, int N, int K, int G_, int c_, const void* Bt_) { nM = M / BM; nN = N / BM; nwg = nM * nN; G = G_; c = c_; rowbytes = (unsigned)K * 2u; Bt = (const char*)Bt_; tstepB = (size_t)256 * K * 2; }
    __device__ __forceinline__ bool next(int i, Unit& u) const {
        const long L = (long)i * G + c; if (L >= nwg) return false;
        int wgid = (int)L; { const int q = nwg / NXCD, r = nwg % NXCD, xcd = wgid % NXCD, off = wgid / NXCD; wgid = (xcd < r ? xcd * (q + 1) : r * (q + 1) + (xcd - r) * q) + off; }
        const int nig = WGM * nN, gid = wgid / nig, fm = gid * WGM, gsz = (nM - fm) < WGM ? (nM - fm) : WGM;
        u.pm = fm + ((wgid % nig) % gsz); u.pn = (wgid % nig) / gsz; u.e = 0; u.cnt = 1 << 30; u.tb = 0; return true;
    }
    __device__ __forceinline__ unsigned arow(const Unit& u, int r) const { return (unsigned)(u.pm * BM + r) * rowbytes; }
    __device__ __forceinline__ const char* bbase(const Unit& u) const { return Bt + (size_t)u.pn * tstepB; }
};
struct MoeSched {
    static constexpr bool DENSE = false; unsigned rowbytes;
    const LAS int* ustart; const LAS int* ecnt; const LAS int* tstart; int total, G, c, NT, mode; const int* list; const char* Bt; size_t estepB, tstepB;
    __device__ __forceinline__ bool next(int i, Unit& u) const {
        const long Lx = (long)i * G + c; if (Lx >= total) return false; const int L = (int)Lx;
        const int ln = (int)__builtin_amdgcn_mbcnt_hi(~0u, __builtin_amdgcn_mbcnt_lo(~0u, 0u));
        const int us = ustart[ln], ue = ustart[ln + 1], ec = ecnt[ln], ts = tstart[ln], us64 = ustart[64], ec64 = ecnt[64], ts64 = tstart[64];
        const unsigned long long bal = __ballot(us <= L && L < ue);
        int lo = 64, usl = us64, ecl = ec64, tsl = ts64;
        if (bal != 0ull) { lo = (int)__ffsll((long long)bal) - 1; usl = __builtin_amdgcn_readlane(us, lo); ecl = __builtin_amdgcn_readlane(ec, lo); tsl = __builtin_amdgcn_readlane(ts, lo); }
        const int loc = L - usl; u.e = lo; u.pm = loc / NT; u.pn = loc % NT; u.cnt = ecl; u.tb = tsl + u.pm; return true;
    }
    __device__ __forceinline__ unsigned arow(const Unit& u, int r) const {
        if (mode == 1) return (unsigned)(u.tb * BM + r) * 512u;
        int p = u.pm * BM + r; if (p >= u.cnt) p = 0;
        const int tok = (u.e == 64) ? p : list[(size_t)u.e * TA + p];
        return (unsigned)tok * 2048u;
    }
    __device__ __forceinline__ const char* bbase(const Unit& u) const { return Bt + (size_t)u.e * estepB + (size_t)u.pn * tstepB; }
};

typedef int v8i_t __attribute__((ext_vector_type(8)));
typedef int v4i_t __attribute__((ext_vector_type(4)));
template <class Epi, class Sched, bool ALIGN_EPI, int WSCALE = 0, bool SP2 = false>
__device__ __forceinline__ void gemm_phase(LAS unsigned char* lds, const char* Abase, const int K, const Sched& S, const Epi& E, const int wid0) {
    const int tid = opaque_tid(wid0), wid = __builtin_amdgcn_readfirstlane(tid >> 6), lane = tid & 63, wr = wid >> 2, wc = wid & 3, fr = lane & 15, fq = lane >> 4;
    const int nt = K / BK;
    unsigned voffB[2];
#pragma unroll
    for (int i = 0; i < 2; ++i) { int R, C; stage_rc(tid * 16 + i * 8192, R, C); const int Rb = Epi::PERM ? ((R & ~31) + perm32(R & 31)) : R; voffB[i] = (unsigned)(Rb * K + C) * 2u; }
#define PG8_AOFF(dst0, dst1, U) do { _Pragma("unroll") for (int _i = 0; _i < 2; ++_i) { int _R, _C; stage_rc(tid * 16 + _i * 8192, _R, _C); \
        dst0[_i] = S.arow(U, _R) + (unsigned)_C * 2u; if constexpr (!Sched::DENSE) dst1[_i] = S.arow(U, _R + HALF) + (unsigned)_C * 2u; } } while (0)
    const size_t hstepA = Sched::DENSE ? (size_t)HALF * S.rowbytes : (size_t)0;
#define PG8_CV1 (Sched::DENSE ? cv0 : cv1)
    const size_t hstep = (size_t)HALF * K * 2;
    const unsigned ldsw = (unsigned)wid * 1024u;
    const int aoff = lds_byte(wr * 64 + fr, fq * 8), boff = lds_byte(wc * 32 + fr, fq * 8);
#define PG8_SA(b, h) (((b) * 2 + (h)) * HTB)
#define PG8_SB(b, h) ((4 + (b) * 2 + (h)) * HTB)
#define PG8_STAGE(bufoff, gbase, voff) do { _Pragma("unroll") for (int _i = 0; _i < 2; ++_i) \
        __builtin_amdgcn_global_load_lds((const unsigned*)((const char*)(gbase) + (voff)[_i]), (LAS unsigned*)(lds + (bufoff) + ldsw + _i * 8192), 16, 0, 0); } while (0)
#define PG8_LDA(dst, b, h) do { _Pragma("unroll") for (int m = 0; m < 4; ++m) { const v4i_t lo_ = *(const LAS v4i_t*)(lds + PG8_SA(b, h) + aoff + m * 2048), hi_ = *(const LAS v4i_t*)(lds + PG8_SA(b, h) + aoff + m * 2048 + 1024); \
        dst[m] = __builtin_shufflevector(lo_, hi_, 0, 1, 2, 3, 4, 5, 6, 7); } } while (0)
#define PG8_LDB(dst, b, h) do { _Pragma("unroll") for (int n = 0; n < 2; ++n) { const v4i_t lo_ = *(const LAS v4i_t*)(lds + PG8_SB(b, h) + boff + n * 2048), hi_ = *(const LAS v4i_t*)(lds + PG8_SB(b, h) + boff + n * 2048 + 1024); \
        dst[n] = __builtin_shufflevector(lo_, hi_, 0, 1, 2, 3, 4, 5, 6, 7); } } while (0)
#define PG8_LO(x) __builtin_bit_cast(bf16x8, __builtin_shufflevector(x, x, 0, 1, 2, 3))
#define PG8_HI(x) __builtin_bit_cast(bf16x8, __builtin_shufflevector(x, x, 4, 5, 6, 7))
#define PG8_MMA(ai, bj, At, Bt) do { __builtin_amdgcn_s_setprio(1); _Pragma("unroll") for (int m = 0; m < 4; ++m) _Pragma("unroll") for (int n = 0; n < 2; ++n) { \
        if constexpr (WSCALE != 0) asm volatile("v_mfma_scale_f32_16x16x128_f8f6f4 %0, %1, %2, %0, %3, %4 op_sel_hi:[0,0,0]" : "+v"(acc[ai][bj][m][n]) : "v"(Bt[n]), "v"(At[m]), "v"(scw), "v"(sca)); \
        else { acc[ai][bj][m][n] = __builtin_amdgcn_mfma_f32_16x16x32_bf16(PG8_LO(Bt[n]), PG8_LO(At[m]), acc[ai][bj][m][n], 0, 0, 0); \
               acc[ai][bj][m][n] = __builtin_amdgcn_mfma_f32_16x16x32_bf16(PG8_HI(Bt[n]), PG8_HI(At[m]), acc[ai][bj][m][n], 0, 0, 0); } } \
        __builtin_amdgcn_s_setprio(0); } while (0)
#define PG8_WAIT_V(n) asm volatile("s_waitcnt vmcnt(" #n ")" ::: "memory")
#define PG8_WAIT_L(n) asm volatile("s_waitcnt lgkmcnt(" #n ")" ::: "memory")
#define PG8_BAR __builtin_amdgcn_s_barrier()
#define PG8_SCHED __builtin_amdgcn_sched_barrier(0)
    Unit cur, nxt; int ui = 0;
    if (!S.next(0, cur)) return;
    f32x4 acc[2][2][4][2];
#pragma unroll
    for (int a = 0; a < 2; ++a)
#pragma unroll
        for (int b = 0; b < 2; ++b)
#pragma unroll
            for (int m = 0; m < 4; ++m)
#pragma unroll
                for (int n = 0; n < 2; ++n) acc[a][b][m][n] = (f32x4){0.f, 0.f, 0.f, 0.f};
    v8i_t At[4], B0[2], B1[2];
    int scw = WSCALE, sca = 127; asm volatile("" : "+v"(scw), "+v"(sca));
    unsigned cv0[2], cv1[2];
    PG8_AOFF(cv0, cv1, cur);
    const char* cB = S.bbase(cur);
    if constexpr (SP2) {
        PG8_STAGE(PG8_SB(0, 0), cB, voffB); PG8_STAGE(PG8_SB(0, 1), cB + hstep, voffB); PG8_STAGE(PG8_SA(0, 0), Abase, cv0); PG8_STAGE(PG8_SA(0, 1), Abase + hstepA, PG8_CV1);
        if (wr == 1) PG8_BAR;
        PG8_WAIT_V(2); PG8_BAR;
    } else {
        PG8_STAGE(PG8_SB(0, 0), cB, voffB); PG8_STAGE(PG8_SA(0, 0), Abase, cv0); PG8_STAGE(PG8_SB(0, 1), cB + hstep, voffB); PG8_STAGE(PG8_SA(0, 1), Abase + hstepA, PG8_CV1);
        if (wr == 1) PG8_BAR;
        PG8_WAIT_V(4); PG8_BAR;
    }
    PG8_STAGE(PG8_SB(1, 0), cB + 128, voffB); PG8_STAGE(PG8_SA(1, 0), Abase + 128, cv0); PG8_STAGE(PG8_SB(1, 1), cB + hstep + 128, voffB);
    PG8_WAIT_V(6); PG8_BAR;
#define PG8_TRIP(LASTF) do { \
        const char* a1 = Abase + (size_t)(t + 1) * 128; \
        const char* a2 = Abase + ((LASTF) ? (size_t)0 : (size_t)(t + 2) * 128); const char* b2 = (LASTF) ? nB : cB + (size_t)(t + 2) * 128; \
        const char* a3 = a2 + 128; const char* b3 = b2 + 128; \
        PG8_LDB(B0, 0, 0); PG8_SCHED; PG8_LDA(At, 0, 0); PG8_STAGE(PG8_SA(1, 1), a1 + hstepA, PG8_CV1); \
        PG8_WAIT_L(8); PG8_BAR; PG8_WAIT_L(0); PG8_MMA(0, 0, At, B0); PG8_BAR; PG8_SCHED; \
        if (LASTF) { if (has_next) PG8_AOFF(cv0, cv1, nxt); } \
        PG8_LDB(B1, 0, 1); PG8_STAGE(PG8_SB(0, 0), b2, voffB); \
        PG8_BAR; PG8_WAIT_L(0); PG8_MMA(0, 1, At, B1); PG8_BAR; \
        PG8_LDA(At, 0, 1); PG8_STAGE(PG8_SA(0, 0), a2, cv0); \
        PG8_BAR; PG8_WAIT_L(0); PG8_MMA(1, 0, At, B0); PG8_BAR; PG8_SCHED; \
        PG8_STAGE(PG8_SB(0, 1), b2 + hstep, voffB); \
        PG8_WAIT_V(6); PG8_BAR; PG8_MMA(1, 1, At, B1); PG8_BAR; \
        PG8_LDB(B0, 1, 0); PG8_SCHED; PG8_LDA(At, 1, 0); PG8_STAGE(PG8_SA(0, 1), a2 + hstepA, PG8_CV1); \
        PG8_WAIT_L(8); PG8_BAR; PG8_WAIT_L(0); PG8_MMA(0, 0, At, B0); PG8_BAR; PG8_SCHED; \
        PG8_LDB(B1, 1, 1); PG8_STAGE(PG8_SB(1, 0), b3, voffB); \
        PG8_BAR; PG8_WAIT_L(0); PG8_MMA(0, 1, At, B1); PG8_BAR; \
        PG8_LDA(At, 1, 1); PG8_STAGE(PG8_SA(1, 0), a3, cv0); \
        PG8_BAR; PG8_WAIT_L(0); PG8_MMA(1, 0, At, B0); PG8_BAR; PG8_SCHED; \
        PG8_STAGE(PG8_SB(1, 1), b3 + hstep, voffB); \
        PG8_WAIT_V(6); PG8_BAR; PG8_MMA(1, 1, At, B1); PG8_BAR; \
    } while (0)
#define PG8_TRIP2(LASTF) do { \
        const char* a1 = Abase + (size_t)(t + 1) * 128; \
        const char* a2 = Abase + ((LASTF) ? (size_t)0 : (size_t)(t + 2) * 128); const char* b2 = (LASTF) ? nB : cB + (size_t)(t + 2) * 128; \
        const char* a3 = a2 + 128; const char* b3 = b2 + 128; \
        PG8_LDB(B0, 0, 0); PG8_LDB(B1, 0, 1); PG8_SCHED; PG8_LDA(At, 0, 0); PG8_STAGE(PG8_SA(1, 1), a1 + hstepA, PG8_CV1); \
        PG8_WAIT_V(8); PG8_WAIT_L(0); PG8_BAR; PG8_MMA(0, 0, At, B0); PG8_MMA(0, 1, At, B1); PG8_BAR; PG8_SCHED; \
        if (LASTF) { if (has_next) PG8_AOFF(cv0, cv1, nxt); } \
        PG8_LDA(At, 0, 1); PG8_STAGE(PG8_SB(0, 0), b2, voffB); PG8_STAGE(PG8_SB(0, 1), b2 + hstep, voffB); PG8_STAGE(PG8_SA(0, 0), a2, cv0); \
        PG8_WAIT_V(8); PG8_WAIT_L(0); PG8_BAR; PG8_MMA(1, 0, At, B0); PG8_MMA(1, 1, At, B1); PG8_BAR; PG8_SCHED; \
        PG8_LDB(B0, 1, 0); PG8_LDB(B1, 1, 1); PG8_SCHED; PG8_LDA(At, 1, 0); PG8_STAGE(PG8_SA(0, 1), a2 + hstepA, PG8_CV1); \
        PG8_WAIT_V(8); PG8_WAIT_L(0); PG8_BAR; PG8_MMA(0, 0, At, B0); PG8_MMA(0, 1, At, B1); PG8_BAR; PG8_SCHED; \
        PG8_LDA(At, 1, 1); PG8_STAGE(PG8_SB(1, 0), b3, voffB); PG8_STAGE(PG8_SB(1, 1), b3 + hstep, voffB); PG8_STAGE(PG8_SA(1, 0), a3, cv0); \
        PG8_WAIT_V(8); PG8_WAIT_L(0); PG8_BAR; PG8_MMA(1, 0, At, B0); PG8_MMA(1, 1, At, B1); PG8_BAR; PG8_SCHED; \
    } while (0)
    for (;;) {
        const bool has_next = S.next(ui + 1, nxt);
        const char* nB = has_next ? S.bbase(nxt) : cB;
        int t = 0;
#pragma nounroll
        for (; t < nt - 2; t += 2) { if constexpr (Epi::ASPLIT >= 0) { sca = t >= Epi::ASPLIT ? 127 - 4 : 127; asm volatile("" : "+v"(sca)); } if constexpr (SP2) PG8_TRIP2(false); else PG8_TRIP(false); }
        if constexpr (Epi::ASPLIT >= 0) { sca = t >= Epi::ASPLIT ? 127 - 4 : 127; asm volatile("" : "+v"(sca)); }
        if constexpr (SP2) PG8_TRIP2(true); else PG8_TRIP(true);
        if constexpr (ALIGN_EPI) { if (wr == 0) PG8_BAR; }
        if constexpr (WSCALE != 0) asm volatile("s_nop 15\n\ts_nop 15\n\ts_nop 15" ::: "memory");
        E(acc, cur, wr, wc, fr, fq);
        if (!has_next) break;
#pragma unroll
        for (int a = 0; a < 2; ++a)
#pragma unroll
            for (int b = 0; b < 2; ++b)
#pragma unroll
                for (int m = 0; m < 4; ++m)
#pragma unroll
                    for (int n = 0; n < 2; ++n) acc[a][b][m][n] = (f32x4){0.f, 0.f, 0.f, 0.f};
        cur = nxt; cB = nB; ++ui;
        if constexpr (ALIGN_EPI) { if (wr == 1) PG8_BAR; }
    }
    PG8_WAIT_V(0);
    if constexpr (!ALIGN_EPI) { if (wr == 0) PG8_BAR; }
    PG8_BAR;
#undef PG8_TRIP
#undef PG8_TRIP2
#undef PG8_AOFF
#undef PG8_CV1
#undef PG8_SA
#undef PG8_SB
#undef PG8_STAGE
#undef PG8_LDA
#undef PG8_LDB
#undef PG8_MMA
#undef PG8_LO
#undef PG8_HI
#undef PG8_WAIT_V
#undef PG8_WAIT_L
#undef PG8_BAR
#undef PG8_SCHED
}

struct EpiProj {
    static constexpr bool PERM = false; static constexpr int ASPLIT = -1;
    bf16_t* O; int ld; int rope_lo, rope_hi, rope_half;
    const float* tab;
    __device__ __forceinline__ void operator()(const f32x4 (&acc)[2][2][4][2], const Unit& u, int wr, int wc, int fr, int fq) const {
        const int row0 = u.pm * BM + wr * 64 + fr, col0 = u.pn * BM + wc * 32 + 4 * fq;
        const bool lat = (u.pm * BM) < TL;
        const bool rfull = lat && u.pn >= rope_lo && u.pn < rope_hi, rhalf = lat && u.pn == rope_half;
#pragma unroll
        for (int ai = 0; ai < 2; ++ai)
#pragma unroll
            for (int m = 0; m < 4; ++m) {
                const int r = row0 + ai * HALF + m * 16;
                f32x4 cs = (f32x4){1.f, 1.f, 1.f, 1.f}, sn = (f32x4){0.f, 0.f, 0.f, 0.f};
                if (rfull || rhalf) { const int t = r & (SEQ - 1); const int pos = (wc & 1) ? (t & 63) : (t >> 6);
                    cs = *(const f32x4*)(tab + pos * 16 + 4 * fq); sn = *(const f32x4*)(tab + 1024 + pos * 16 + 4 * fq); }
                bf16_t* rowp = O + (size_t)r * ld + col0;
#pragma unroll
                for (int bj = 0; bj < 2; ++bj) {
                    f32x4 x1 = acc[ai][bj][m][0], x2 = acc[ai][bj][m][1];
                    if (rfull || (rhalf && bj == 0)) { const f32x4 y1 = x1 * cs - x2 * sn, y2 = x2 * cs + x1 * sn; x1 = y1; x2 = y2; }
                    u32x2 w0, w1; w0.x = cvt_pk(x1[0], x1[1]); w0.y = cvt_pk(x1[2], x1[3]); w1.x = cvt_pk(x2[0], x2[1]); w1.y = cvt_pk(x2[2], x2[3]);
                    *(u32x2*)(rowp + bj * HALF) = w0; *(u32x2*)(rowp + bj * HALF + 16) = w1;
                }
            }
    }
};
template <bool BASE_BF16> struct EpiOutRes {
    static constexpr bool PERM = false; static constexpr int ASPLIT = BASE_BF16 ? 0 : 8;
    const float* base_lat; const float* base_ctx; bf16_t* out; const float* gate;
    __device__ __forceinline__ void operator()(const f32x4 (&acc)[2][2][4][2], const Unit& u, int wr, int wc, int fr, int fq) const {
        const int row0 = u.pm * BM + wr * 64 + fr, col0 = u.pn * BM + wc * 32 + 4 * fq;
        const bool lat = (u.pm * BM) < TL; const int rt = lat ? (u.pm >> 4) : 4;
        const float* bs = lat ? base_lat : base_ctx - (size_t)TL * D;
        f32x4 gv[2][2];
#pragma unroll
        for (int bj = 0; bj < 2; ++bj)
#pragma unroll
            for (int n = 0; n < 2; ++n) gv[bj][n] = *(const f32x4*)(gate + (size_t)rt * MODW + col0 + bj * HALF + n * 16);
#pragma unroll
        for (int ai = 0; ai < 2; ++ai)
#pragma unroll
            for (int m = 0; m < 4; ++m) { const size_t off = (size_t)(row0 + ai * HALF + m * 16) * D + col0;
#pragma unroll
                for (int bj = 0; bj < 2; ++bj)
#pragma unroll
                    for (int n = 0; n < 2; ++n) { f32x4 b;
                        if constexpr (BASE_BF16) { const u32x2 w = *(const u32x2*)(out + off + bj * HALF + n * 16); b = (f32x4){bflo(w.x), bfhi(w.x), bflo(w.y), bfhi(w.y)}; }
                        else b = *(const f32x4*)(bs + off + bj * HALF + n * 16);
                        const f32x4 y = b + gv[bj][n] * acc[ai][bj][m][n]; u32x2 o; o.x = cvt_pk(y[0], y[1]); o.y = cvt_pk(y[2], y[3]); *(u32x2*)(out + off + bj * HALF + n * 16) = o; }
                asm volatile("" ::: "memory"); }
    }
};
struct EpiGateUp {
    static constexpr bool PERM = true; static constexpr int ASPLIT = -1;
    unsigned char* hid;
    __device__ __forceinline__ void operator()(const f32x4 (&acc)[2][2][4][2], const Unit& u, int wr, int wc, int fr, int fq) const {
        const int colh = u.pn * 128 + wc * 32 + 8 * fq;
#pragma unroll
        for (int ai = 0; ai < 2; ++ai)
#pragma unroll
            for (int m = 0; m < 4; ++m) {
                unsigned char* rowp = hid + (size_t)(u.tb * BM + ai * HALF + wr * 64 + m * 16 + fr) * DEXP + colh;
                u32x2 o;
#pragma unroll
                for (int n = 0; n < 2; ++n) { const f32x4 g = acc[ai][0][m][n], up = acc[ai][1][m][n]; f32x4 h;
#pragma unroll
                    for (int j = 0; j < 4; ++j) h[j] = g[j] * __builtin_amdgcn_rcpf(1.0f + __expf(-g[j])) * up[j];
                    int w = 0; w = __builtin_amdgcn_cvt_pk_fp8_f32(h[0], h[1], w, false); w = __builtin_amdgcn_cvt_pk_fp8_f32(h[2], h[3], w, true);
                    if (n == 0) o.x = (unsigned)w; else o.y = (unsigned)w; }
                *(u32x2*)rowp = o;
            }
    }
};
struct EpiDown {
    static constexpr bool PERM = true; static constexpr int ASPLIT = -1;
    unsigned char* y;
    __device__ __forceinline__ void operator()(const f32x4 (&acc)[2][2][4][2], const Unit& u, int wr, int wc, int fr, int fq) const {
        const int col0 = u.pn * BM + wc * 32 + 8 * fq;
#pragma unroll
        for (int ai = 0; ai < 2; ++ai)
#pragma unroll
            for (int m = 0; m < 4; ++m) {
                unsigned char* rowp = y + (size_t)(u.tb * BM + ai * HALF + wr * 64 + m * 16 + fr) * D + col0;
#pragma unroll
                for (int bj = 0; bj < 2; ++bj) { const f32x4 v0 = acc[ai][bj][m][0], v1 = acc[ai][bj][m][1]; int w0 = 0, w1 = 0;
                    w0 = __builtin_amdgcn_cvt_pk_fp8_f32(v0[0], v0[1], w0, false); w0 = __builtin_amdgcn_cvt_pk_fp8_f32(v0[2], v0[3], w0, true);
                    w1 = __builtin_amdgcn_cvt_pk_fp8_f32(v1[0], v1[1], w1, false); w1 = __builtin_amdgcn_cvt_pk_fp8_f32(v1[2], v1[3], w1, true);
                    u32x2 o; o.x = (unsigned)w0; o.y = (unsigned)w1; *(u32x2*)(rowp + bj * HALF) = o; }
            }
    }
};
}

namespace ga {
constexpr int DH = 128, QBLK = 32, KVBLK = 64, LDQ = 2048, LDK = 512, LDO = 2048;
constexpr float SCALE = 0.088388347648318440f;
constexpr float THR = 5.f;
constexpr size_t SHM_V = KVBLK * DH * 2, SHM_K = KVBLK * DH * 2, SHM_ATTN = 2 * SHM_V + 2 * SHM_K + NWAVES * 64 * 4;
typedef float f32x16 __attribute__((ext_vector_type(16)));
#define KSWZ(row, colB) ((row) * 256 + ((colB) ^ (((row) & 7) << 4)))
#define SBAR() __builtin_amdgcn_sched_barrier(0)
__device__ __forceinline__ int crow(int r, int hi) { return (r & 3) + 8 * (r >> 2) + 4 * hi; }
__device__ __forceinline__ void partialSM(f32x16& p0, f32x16& p1, float& m_reg, float& mn, float& alpha) {
  constexpr float C = SCALE * 1.4426950408889634f;
  float pmax = p0[0]; for (int r = 1; r < 16; ++r) pmax = fmaxf(pmax, p0[r]); for (int r = 0; r < 16; ++r) pmax = fmaxf(pmax, p1[r]);
  { auto rr = __builtin_amdgcn_permlane32_swap(__float_as_uint(pmax), __float_as_uint(pmax), false, false);
    pmax = fmaxf(__uint_as_float(rr[0]), __uint_as_float(rr[1])); }
  if (__builtin_expect(__all(pmax - m_reg <= THR / SCALE), 1)) { mn = m_reg; alpha = 1.f; }
  else { mn = fmaxf(m_reg, pmax); alpha = __builtin_amdgcn_exp2f((m_reg - mn) * C); m_reg = mn; }
  float mnC = -mn * C;
  for (int r = 0; r < 16; ++r) p0[r] = fmaf(p0[r], C, mnC); for (int r = 0; r < 16; ++r) p1[r] = fmaf(p1[r], C, mnC);
  for (int r = 0; r < 16; ++r) p0[r] = __builtin_amdgcn_exp2f(p0[r]);
}
typedef int v8i_p __attribute__((ext_vector_type(8)));
__device__ __forceinline__ void finishSM(f32x16& p0, f32x16& p1, float alpha, float& l_reg, v8i_p& pf) {
  for (int r = 0; r < 16; ++r) p1[r] = __builtin_amdgcn_exp2f(p1[r]);
  float ps = 0; for (int r = 0; r < 16; ++r) ps += p0[r]; for (int r = 0; r < 16; ++r) ps += p1[r];
  { auto rr = __builtin_amdgcn_permlane32_swap(__float_as_uint(ps), __float_as_uint(ps), false, false);
    ps = __uint_as_float(rr[0]) + __uint_as_float(rr[1]); }
  l_reg = l_reg * alpha + ps;
#pragma unroll
  for (int i = 0; i < 4; ++i) { int w = 0; w = __builtin_amdgcn_cvt_pk_fp8_f32(p0[4 * i], p0[4 * i + 1], w, false); w = __builtin_amdgcn_cvt_pk_fp8_f32(p0[4 * i + 2], p0[4 * i + 3], w, true); pf[i] = w;
    int u = 0; u = __builtin_amdgcn_cvt_pk_fp8_f32(p1[4 * i], p1[4 * i + 1], u, false); u = __builtin_amdgcn_cvt_pk_fp8_f32(p1[4 * i + 2], p1[4 * i + 3], u, true); pf[4 + i] = u; }
}
typedef int v8i_a __attribute__((ext_vector_type(8)));
typedef int v4i_a __attribute__((ext_vector_type(4)));
__device__ __forceinline__ int k8_off(int row, int chunk) { return row * 128 + ((chunk ^ ((row >> 1) & 7)) << 4); }
__device__ __forceinline__ void qkt(f32x16& p0, f32x16& p1, const char* Ks, const v8i_a* q8, int r32, int hi) {
  p0 = f32x16{}; p1 = f32x16{};
#pragma unroll
  for (int m = 0; m < 2; ++m) {
    const v4i_a a0l = *reinterpret_cast<const v4i_a*>(Ks + k8_off(r32, hi * 4 + 2 * m)), a0h = *reinterpret_cast<const v4i_a*>(Ks + k8_off(r32, hi * 4 + 2 * m + 1));
    const v4i_a a1l = *reinterpret_cast<const v4i_a*>(Ks + k8_off(32 + r32, hi * 4 + 2 * m)), a1h = *reinterpret_cast<const v4i_a*>(Ks + k8_off(32 + r32, hi * 4 + 2 * m + 1));
    const v8i_a a0 = __builtin_shufflevector(a0l, a0h, 0, 1, 2, 3, 4, 5, 6, 7), a1 = __builtin_shufflevector(a1l, a1h, 0, 1, 2, 3, 4, 5, 6, 7);
    p0 = __builtin_amdgcn_mfma_scale_f32_32x32x64_f8f6f4(a0, q8[m], p0, 0, 0, 0, 127, 0, 127);
    p1 = __builtin_amdgcn_mfma_scale_f32_32x32x64_f8f6f4(a1, q8[m], p1, 0, 0, 0, 127, 0, 127); }
}
__device__ __forceinline__ int vt_off(int d, int byte) { return d * 64 + ((((byte >> 4) ^ ((d >> 2) & 3))) << 4) + (byte & 15); }
__device__ __forceinline__ int vt_pos(int k) { const int k32 = k & 31; return ((k32 >> 2) & 1) * 32 + (k >> 5) * 16 + (k32 & 3) + 4 * (k32 >> 3); }
template <int D0> __device__ __forceinline__ void pv_one(f32x16& od, const char* VT, v8i_p pf, int r32, int hi) {
  const int d = 32 * D0 + r32;
  const v4i_a bl = *reinterpret_cast<const v4i_a*>(VT + vt_off(d, 32 * hi)), bh = *reinterpret_cast<const v4i_a*>(VT + vt_off(d, 32 * hi + 16));
  od = __builtin_amdgcn_mfma_scale_f32_32x32x64_f8f6f4(pf, __builtin_shufflevector(bl, bh, 0, 1, 2, 3, 4, 5, 6, 7), od, 0, 0, 0, 127, 0, 127);
}
__device__ __forceinline__ void pv_d0(f32x16* o, const char* VT, v8i_p pf, int r32, int hi) {
  pv_one<0>(o[0], VT, pf, r32, hi); pv_one<1>(o[1], VT, pf, r32, hi); pv_one<2>(o[2], VT, pf, r32, hi); pv_one<3>(o[3], VT, pf, r32, hi);
}
__device__ __forceinline__ u32x2 k8pack(bf16x8 v) { const u32x4 w = __builtin_bit_cast(u32x4, v); int a = 0, b = 0;
  a = __builtin_amdgcn_cvt_pk_fp8_f32(bflo(w.x), bfhi(w.x), a, false); a = __builtin_amdgcn_cvt_pk_fp8_f32(bflo(w.y), bfhi(w.y), a, true); b = __builtin_amdgcn_cvt_pk_fp8_f32(bflo(w.z), bfhi(w.z), b, false); b = __builtin_amdgcn_cvt_pk_fp8_f32(bflo(w.w), bfhi(w.w), b, true);
  u32x2 o; o.x = (unsigned)a; o.y = (unsigned)b; return o; }
__device__ __forceinline__ void attn_dense_body(const bf16_t* __restrict__ Qb, const float* __restrict__ gq, const float* __restrict__ tab, int t0, const unsigned char* __restrict__ Kh, const unsigned char* __restrict__ Vh,
                                                unsigned char* __restrict__ Ob, int seq, char* lds, const int wid0) {
  const int tid = opaque_tid(wid0), wid = tid >> 6, lane = tid & 63, r32 = lane & 31, hi = lane >> 5;
  char* V_lds = lds; char* K_lds = lds + 2 * SHM_V;
  float* ws = (float*)(lds + 2 * SHM_V + 2 * SHM_K) + wid * 64; float* li_l = ws; float* al_l = ws + 32;
  float m_reg = -1e30f, l_reg = 0; f32x16 o[4] = {}; v8i_a qr[2];
  { const bf16_t* Qw = Qb + (long)(wid * QBLK + r32) * ODD_IN + hi * 8;
    u32x4 raw[8]; float ss = 0.f;
#pragma unroll
    for (int d0 = 0; d0 < 8; ++d0) { raw[d0] = *reinterpret_cast<const u32x4*>(Qw + d0 * 16);
      const float a0 = bflo(raw[d0].x), a1 = bfhi(raw[d0].x), a2 = bflo(raw[d0].y), a3 = bfhi(raw[d0].y), a4 = bflo(raw[d0].z), a5 = bfhi(raw[d0].z), a6 = bflo(raw[d0].w), a7 = bfhi(raw[d0].w);
      ss += (a0 * a0 + a1 * a1) + (a2 * a2 + a3 * a3) + (a4 * a4 + a5 * a5) + (a6 * a6 + a7 * a7); }
    ss += __shfl_xor(ss, 32);
    const float rstd = rsqrtf(ss * (1.0f / 128.0f) + EPS);
    const int t = t0 + wid * QBLK + r32, posr = t >> 6, posc = t & 63;
#pragma unroll
    for (int d0 = 0; d0 < 8; ++d0) { const int hf = d0 >> 2, pos = hf ? posc : posr, jb = 8 * (d0 & 3) + 4 * hi;
      const f32x4 cs = *(const f32x4*)(tab + pos * 32 + jb), sn = *(const f32x4*)(tab + 2048 + pos * 32 + jb), g1 = *(const f32x4*)(gq + 64 * hf + jb) * rstd, g2 = *(const f32x4*)(gq + 64 * hf + 32 + jb) * rstd;
      const unsigned rw[4] = {raw[d0].x, raw[d0].y, raw[d0].z, raw[d0].w}; float oo[8];
#pragma unroll
      for (int pi = 0; pi < 4; ++pi) { const float y1 = bflo(rw[pi]) * g1[pi], y2 = bfhi(rw[pi]) * g2[pi]; oo[2 * pi] = y1 * cs[pi] - y2 * sn[pi]; oo[2 * pi + 1] = y2 * cs[pi] + y1 * sn[pi]; }
      int wa = 0, wb = 0; wa = __builtin_amdgcn_cvt_pk_fp8_f32(oo[0], oo[1], wa, false); wa = __builtin_amdgcn_cvt_pk_fp8_f32(oo[2], oo[3], wa, true); wb = __builtin_amdgcn_cvt_pk_fp8_f32(oo[4], oo[5], wb, false); wb = __builtin_amdgcn_cvt_pk_fp8_f32(oo[6], oo[7], wb, true);
      qr[d0 >> 2][2 * (d0 & 3)] = wa; qr[d0 >> 2][2 * (d0 & 3) + 1] = wb; } }
  struct { bf16x8 vs0, ks0; } sr_[2];
#define SLOAD(i, k0) do { sr_[i].vs0 = *reinterpret_cast<const bf16x8*>(Vh + (size_t)((k0) >> 6) * 8192 + tid * 16); sr_[i].ks0 = *reinterpret_cast<const bf16x8*>(Kh + (size_t)((k0) >> 6) * 8192 + tid * 16); } while (0)
#define SWRITE(b, i) do { *(bf16x8*)(V_lds + (b) * SHM_V + tid * 16) = sr_[i].vs0; *(bf16x8*)(K_lds + (b) * SHM_K + tid * 16) = sr_[i].ks0; } while (0)
#define SWAIT() asm volatile("s_waitcnt vmcnt(2)" ::: "memory")
#define RESC(a) do { if (__any((a) < 1.f)) { if (hi == 0) al_l[r32] = (a); asm volatile("s_waitcnt lgkmcnt(0)" ::: "memory"); \
    for (int d = 0; d < 4; ++d) for (int r = 0; r < 16; ++r) o[d][r] *= al_l[crow(r, hi)]; } } while (0)
  f32x16 pA0, pA1, pB0, pB1; float mnA, mnB, alA, alB; v8i_p pf; const int NT = seq / KVBLK;
  constexpr int SE = 0, SO = 1;
  SLOAD(SE, 0); asm volatile("s_waitcnt vmcnt(0)" ::: "memory"); SWRITE(0, SE); __syncthreads();
  qkt(pA0, pA1, K_lds, qr, r32, hi); partialSM(pA0, pA1, m_reg, mnA, alA);
  SLOAD(SO, KVBLK); if (2 < NT) SLOAD(SE, 2 * KVBLK);
  SWAIT(); SWRITE(1, SO); __syncthreads();
  for (int j = 1; j + 1 < NT; j += 2) {
    SBAR(); qkt(pB0, pB1, K_lds + SHM_K, qr, r32, hi);
    finishSM(pA0, pA1, alA, l_reg, pf); SBAR();
    SLOAD(SO, (j + 2) * KVBLK); SBAR();
    pv_d0(o, V_lds, pf, r32, hi); partialSM(pB0, pB1, m_reg, mnB, alB);
    __syncthreads(); SWAIT(); SWRITE(0, SE);
    RESC(alB); __syncthreads();
    SBAR(); qkt(pA0, pA1, K_lds, qr, r32, hi);
    finishSM(pB0, pB1, alB, l_reg, pf); SBAR();
    if (j + 3 < NT) SLOAD(SE, (j + 3) * KVBLK); SBAR();
    pv_d0(o, V_lds + SHM_V, pf, r32, hi); partialSM(pA0, pA1, m_reg, mnA, alA);
    __syncthreads(); SWAIT(); SWRITE(1, SO);
    RESC(alA); __syncthreads();
  }
  SBAR(); qkt(pB0, pB1, K_lds + SHM_K, qr, r32, hi);
  finishSM(pA0, pA1, alA, l_reg, pf); SBAR();
  pv_d0(o, V_lds, pf, r32, hi); partialSM(pB0, pB1, m_reg, mnB, alB);
  __syncthreads(); RESC(alB);
  finishSM(pB0, pB1, alB, l_reg, pf); SBAR();
  pv_d0(o, V_lds + SHM_V, pf, r32, hi);
  if (hi == 0) li_l[r32] = l_reg; asm volatile("s_waitcnt lgkmcnt(0)" ::: "memory");
  float rli[16];
#pragma unroll
  for (int r = 0; r < 16; ++r) rli[r] = __builtin_amdgcn_rcpf(li_l[crow(r, hi)]);
  unsigned char* Ow = Ob + (long)(wid * QBLK) * LDO;
#pragma unroll
  for (int r = 0; r < 16; ++r) { int orow = crow(r, hi);
    for (int d0 = 0; d0 < 4; ++d0) Ow[(long)orow * LDO + d0 * 32 + r32] = f2fp8(o[d0][r] * rli[r] * 16.0f); }
  __syncthreads();
#undef SLOAD
#undef SWRITE
#undef SWAIT
#undef RESC
}
}

__device__ __forceinline__ void win_attn_item(char* lds, const bf16_t* __restrict__ P, bf16_t* __restrict__ cat, const float* __restrict__ sink, int b, int h, int qb, bool isctx, const int wid0) {
    const int tid = opaque_tid(wid0), wid = tid >> 6, lane = tid & 63, lq = lane & 15, g = lane >> 4;
    const int kvh = h >> 3;
    char* Ks = lds; char* Vs = lds + 128 * 144;
    const size_t qrow0 = isctx ? (size_t)(TL + b * CTXL + qb * 128) : (size_t)(b * SEQ + qb * 128);
    const bf16_t* qp = P + (qrow0 + wid * 16 + lq) * EVEN_IN + 5120 + h * 64 + 8 * g;
    const bf16x8 qf0 = *(const bf16x8*)qp, qf1 = *(const bf16x8*)(qp + 32);
    float m = sink[h], l = 1.0f;
    f32x4 o[4];
#pragma unroll
    for (int dt = 0; dt < 4; ++dt) o[dt] = (f32x4){0.f, 0.f, 0.f, 0.f};
    const int ntile = isctx ? 2 : 5;
    const int iq = wid * 16 + lq;
    for (int ti = 0; ti < ntile; ++ti) {
        int kind; size_t krow0;
        if (isctx) { kind = 3; krow0 = (size_t)(TL + b * CTXL + ti * 128); }
        else if (ti < 3) { const int kbi = qb - 1 + ti; if (kbi < 0 || kbi >= SEQ / 128) continue; kind = ti; krow0 = (size_t)(b * SEQ + kbi * 128); }
        else { kind = 3; krow0 = (size_t)(TL + b * CTXL + (ti - 3) * 128); }
        __syncthreads();
        { const int r = tid >> 2, c = (tid & 3) * 16; const bf16_t* kp = P + (krow0 + r) * EVEN_IN + 6144 + kvh * 64 + c; const bf16_t* vp = kp + 128;
          const bf16x8 k0 = *(const bf16x8*)kp, k1 = *(const bf16x8*)(kp + 8), v0 = *(const bf16x8*)vp, v1 = *(const bf16x8*)(vp + 8);
          *(bf16x8*)(Ks + r * 144 + c * 2) = k0; *(bf16x8*)(Ks + r * 144 + c * 2 + 16) = k1;
          *(bf16x8*)(Vs + r * 144 + c * 2) = v0; *(bf16x8*)(Vs + r * 144 + c * 2 + 16) = v1; }
        __syncthreads();
        f32x4 st[8];
#pragma unroll
        for (int kt = 0; kt < 8; ++kt) {
            const bf16x8 kf0 = *(const bf16x8*)(Ks + (16 * kt + lq) * 144 + 16 * g), kf1 = *(const bf16x8*)(Ks + (16 * kt + lq) * 144 + 64 + 16 * g);
            f32x4 a = (f32x4){0.f, 0.f, 0.f, 0.f};
            a = __builtin_amdgcn_mfma_f32_16x16x32_bf16(kf0, qf0, a, 0, 0, 0);
            a = __builtin_amdgcn_mfma_f32_16x16x32_bf16(kf1, qf1, a, 0, 0, 0);
            st[kt] = a;
        }
        float tm = -INFINITY;
#pragma unroll
        for (int kt = 0; kt < 8; ++kt)
#pragma unroll
            for (int i = 0; i < 4; ++i) { float s = st[kt][i] * 0.125f; const int jj = 16 * kt + 4 * g + i;
                if (kind == 0 && jj < iq) s = -INFINITY; if (kind == 2 && jj > iq) s = -INFINITY; st[kt][i] = s; tm = fmaxf(tm, s); }
        tm = fmaxf(tm, __shfl_xor(tm, 16)); tm = fmaxf(tm, __shfl_xor(tm, 32));
        const float mn = fmaxf(m, tm), alpha = __expf(m - mn); m = mn;
        float ps = 0.f;
#pragma unroll
        for (int kt = 0; kt < 8; ++kt)
#pragma unroll
            for (int i = 0; i < 4; ++i) { const float p = __expf(st[kt][i] - mn); st[kt][i] = p; ps += p; }
        ps += __shfl_xor(ps, 16); ps += __shfl_xor(ps, 32);
        l = l * alpha + ps;
#pragma unroll
        for (int i = 0; i < 4; ++i) { const float a = __shfl(alpha, 4 * g + i);
#pragma unroll
            for (int dt = 0; dt < 4; ++dt) o[dt][i] *= a; }
#pragma unroll
        for (int tp = 0; tp < 4; ++tp) {
            u32x4 pw; pw.x = cvt_pk(st[2 * tp][0], st[2 * tp][1]); pw.y = cvt_pk(st[2 * tp][2], st[2 * tp][3]); pw.z = cvt_pk(st[2 * tp + 1][0], st[2 * tp + 1][1]); pw.w = cvt_pk(st[2 * tp + 1][2], st[2 * tp + 1][3]);
            const bf16x8 pf = *reinterpret_cast<bf16x8*>(&pw);
#pragma unroll
            for (int dt = 0; dt < 4; ++dt) {
                const s16x4 v0 = __builtin_amdgcn_ds_read_tr16_b64_v4i16((LAS s16x4*)(Vs + (32 * tp + 4 * g + (lq >> 2)) * 144 + (16 * dt + 4 * (lq & 3)) * 2));
                const s16x4 v1 = __builtin_amdgcn_ds_read_tr16_b64_v4i16((LAS s16x4*)(Vs + (32 * tp + 16 + 4 * g + (lq >> 2)) * 144 + (16 * dt + 4 * (lq & 3)) * 2));
                const bf16x8 vf = (bf16x8){v0[0], v0[1], v0[2], v0[3], v1[0], v1[1], v1[2], v1[3]};
                o[dt] = __builtin_amdgcn_mfma_f32_16x16x32_bf16(pf, vf, o[dt], 0, 0, 0);
            }
        }
    }
#pragma unroll
    for (int i = 0; i < 4; ++i) { const float inv = 1.0f / __shfl(l, 4 * g + i);
        bf16_t* op = cat + (qrow0 + wid * 16 + 4 * g + i) * D + 1024 + h * 64 + lq;
#pragma unroll
        for (int dt = 0; dt < 4; ++dt) op[16 * dt] = f2bf(o[dt][i] * inv); }
}

__device__ __forceinline__ void win_attn_item2(char* lds, const bf16_t* __restrict__ P, unsigned char* __restrict__ cat, const float* __restrict__ sink, int b, int kvh, int qb, bool isctx, const int wid0) {
    const int tid = opaque_tid(wid0), wid = tid >> 6, lane = tid & 63, lq = lane & 15, g = lane >> 4;
    const int h = kvh * 8 + wid;
    char* Ks = lds; char* Vs = lds + 64 * 144;
    const size_t qrow0 = isctx ? (size_t)(TL + b * CTXL + qb * 64) : (size_t)(b * SEQ + qb * 64);
    const int q0 = qb * 64;
    bf16x8 qf[4][2];
#pragma unroll
    for (int qt = 0; qt < 4; ++qt) { const bf16_t* qp = P + (qrow0 + 16 * qt + lq) * EVEN_IN + 5120 + h * 64 + 8 * g; qf[qt][0] = *(const bf16x8*)qp; qf[qt][1] = *(const bf16x8*)(qp + 32); }
    float m[4], l[4]; f32x4 o[4][4];
    const float sk = sink[h];
#pragma unroll
    for (int qt = 0; qt < 4; ++qt) { m[qt] = sk; l[qt] = 1.0f;
#pragma unroll
        for (int dt = 0; dt < 4; ++dt) o[qt][dt] = (f32x4){0.f, 0.f, 0.f, 0.f}; }
    const int ntile = isctx ? 4 : 9;
    for (int ti = 0; ti < ntile; ++ti) {
        bool win = false; int kpos0 = 0; size_t krow0;
        if (isctx) krow0 = (size_t)(TL + b * CTXL + ti * 64);
        else if (ti < 5) { win = true; kpos0 = q0 - 128 + 64 * ti; if (kpos0 < 0 || kpos0 >= SEQ) continue; krow0 = (size_t)(b * SEQ + kpos0); }
        else krow0 = (size_t)(TL + b * CTXL + (ti - 5) * 64);
        __syncthreads();
        { const int r = tid >> 3, c = (tid & 7) * 8; const bf16_t* kp = P + (krow0 + r) * EVEN_IN + 6144 + kvh * 64 + c;
          *(bf16x8*)(Ks + r * 144 + c * 2) = *(const bf16x8*)kp; *(bf16x8*)(Vs + r * 144 + c * 2) = *(const bf16x8*)(kp + 128); }
        __syncthreads();
        bf16x8 kf[4][2], vf[2][4];
#pragma unroll
        for (int kt = 0; kt < 4; ++kt) { kf[kt][0] = *(const bf16x8*)(Ks + (16 * kt + lq) * 144 + 16 * g); kf[kt][1] = *(const bf16x8*)(Ks + (16 * kt + lq) * 144 + 64 + 16 * g); }
#pragma unroll
        for (int ks = 0; ks < 2; ++ks)
#pragma unroll
            for (int dt = 0; dt < 4; ++dt) {
                const s16x4 v0 = __builtin_amdgcn_ds_read_tr16_b64_v4i16((LAS s16x4*)(Vs + (32 * ks + 4 * g + (lq >> 2)) * 144 + (16 * dt + 4 * (lq & 3)) * 2));
                const s16x4 v1 = __builtin_amdgcn_ds_read_tr16_b64_v4i16((LAS s16x4*)(Vs + (32 * ks + 16 + 4 * g + (lq >> 2)) * 144 + (16 * dt + 4 * (lq & 3)) * 2));
                vf[ks][dt] = (bf16x8){v0[0], v0[1], v0[2], v0[3], v1[0], v1[1], v1[2], v1[3]}; }
#pragma unroll
        for (int qt = 0; qt < 4; ++qt) {
            f32x4 st[4];
#pragma unroll
            for (int kt = 0; kt < 4; ++kt) { f32x4 a = (f32x4){0.f, 0.f, 0.f, 0.f};
                a = __builtin_amdgcn_mfma_f32_16x16x32_bf16(kf[kt][0], qf[qt][0], a, 0, 0, 0); a = __builtin_amdgcn_mfma_f32_16x16x32_bf16(kf[kt][1], qf[qt][1], a, 0, 0, 0); st[kt] = a; }
            const int qpos = q0 + 16 * qt + lq;
            float tm = -INFINITY;
#pragma unroll
            for (int kt = 0; kt < 4; ++kt)
#pragma unroll
                for (int i = 0; i < 4; ++i) { float sc = st[kt][i] * 0.125f;
                    if (win) { const int d = kpos0 + 16 * kt + 4 * g + i - qpos; if (d < -128 || d > 128) sc = -INFINITY; }
                    st[kt][i] = sc; tm = fmaxf(tm, sc); }
            tm = fmaxf(tm, __shfl_xor(tm, 16)); tm = fmaxf(tm, __shfl_xor(tm, 32));
            const float mn = fmaxf(m[qt], tm), alpha = __expf(m[qt] - mn); m[qt] = mn;
            float ps = 0.f;
#pragma unroll
            for (int kt = 0; kt < 4; ++kt)
#pragma unroll
                for (int i = 0; i < 4; ++i) { const float p = __expf(st[kt][i] - mn); st[kt][i] = p; ps += p; }
            ps += __shfl_xor(ps, 16); ps += __shfl_xor(ps, 32);
            l[qt] = l[qt] * alpha + ps;
#pragma unroll
            for (int i = 0; i < 4; ++i) { const float a = __shfl(alpha, 4 * g + i);
#pragma unroll
                for (int dt = 0; dt < 4; ++dt) o[qt][dt][i] *= a; }
#pragma unroll
            for (int ks = 0; ks < 2; ++ks) {
                u32x4 pw; pw.x = cvt_pk(st[2 * ks][0], st[2 * ks][1]); pw.y = cvt_pk(st[2 * ks][2], st[2 * ks][3]); pw.z = cvt_pk(st[2 * ks + 1][0], st[2 * ks + 1][1]); pw.w = cvt_pk(st[2 * ks + 1][2], st[2 * ks + 1][3]);
                const bf16x8 pf = *reinterpret_cast<bf16x8*>(&pw);
#pragma unroll
                for (int dt = 0; dt < 4; ++dt) o[qt][dt] = __builtin_amdgcn_mfma_f32_16x16x32_bf16(pf, vf[ks][dt], o[qt][dt], 0, 0, 0);
            }
        }
    }
#pragma unroll
    for (int qt = 0; qt < 4; ++qt)
#pragma unroll
        for (int i = 0; i < 4; ++i) { const float inv = 1.0f / __shfl(l[qt], 4 * g + i);
            unsigned char* op = cat + (qrow0 + 16 * qt + 4 * g + i) * D + 1024 + h * 64 + lq;
#pragma unroll
            for (int dt = 0; dt < 4; ++dt) op[16 * dt] = f2fp8(o[qt][dt][i] * inv * 16.0f); }
}

__device__ __forceinline__ float hgrn_lb(const float* __restrict__ lbl, int kk) {
    const float l0 = lbl[kk], l1 = lbl[1024 + kk], l2 = lbl[2048 + kk], mx = fmaxf(l0, fmaxf(l1, l2));
    const float e0 = __expf(l0 - mx), e1 = __expf(l1 - mx), e2 = __expf(l2 - mx);
    return e1 / (e0 + e1 + e2);
}
__device__ __forceinline__ size_t chunk_row0(int b, int ci) { return ci < 64 ? (size_t)(b * SEQ + ci * 64) : (size_t)(TL + b * CTXL + (ci - 64) * 64); }
__device__ __forceinline__ void hgrn_a_item(char* lds, const bf16_t* __restrict__ P, const float* __restrict__ lbl, bf16_t* __restrict__ U, float* __restrict__ DEC, int b, int h, int ci, const int wid0) {
    const int tid = opaque_tid(wid0), wid = tid >> 6, lane = tid & 63, lq = lane & 15, g = lane >> 4;
    const size_t r0 = chunk_row0(b, ci);
    char* WT = lds; char* Vs = lds + 2 * 128 * 144;
    __syncthreads();
    char* FR = lds + 2 * 128 * 144 + 64 * 272;
    {
        const int r = tid >> 3, c = (tid & 7) * 16;
        const bf16_t* vp = P + (r0 + r) * EVEN_IN + 1024 + h * 128 + c;
        const bf16x8 v0 = *(const bf16x8*)vp, v1 = *(const bf16x8*)(vp + 8), a0 = *(const bf16x8*)(vp + 1024), a1 = *(const bf16x8*)(vp + 1032), b0 = *(const bf16x8*)(vp + 2048), b1 = *(const bf16x8*)(vp + 2056);
        *(bf16x8*)(Vs + r * 272 + c * 2) = v0; *(bf16x8*)(Vs + r * 272 + c * 2 + 16) = v1;
        *(bf16x8*)(FR + r * 272 + c * 2) = a0; *(bf16x8*)(FR + r * 272 + c * 2 + 16) = a1;
        *(bf16x8*)(FR + 17408 + r * 272 + c * 2) = b0; *(bf16x8*)(FR + 17408 + r * 272 + c * 2 + 16) = b1;
    }
    __syncthreads();
    {
        const int dir = tid >> 8, k = (tid >> 1) & 127, half = tid & 1, kk = h * 128 + k, s0 = half * 32;
        const float lb = hgrn_lb(lbl, kk);
        const char* fp = FR + dir * 17408 + s0 * 272 + k * 2;
        float f[32], kf[32];
#pragma unroll
        for (int s = 0; s < 32; ++s) f[s] = bf2f(*(const bf16_t*)(fp + s * 272));
        float mine = 0.f;
#pragma unroll
        for (int s = 0; s < 32; ++s) { const float g = lb + (1.0f - lb) * sigmoidf_(f[s]); kf[s] = 1.0f - g; f[s] = __builtin_amdgcn_logf(g); mine += f[s]; }
        const float other = __shfl_xor(mine, 1), tot = mine + other;
        char* wrow = WT + (dir * 128 + k) * 144 + s0 * 2;
        if (dir == 0) {
            float bs = half ? other : 0.f;
#pragma unroll
            for (int s = 0; s < 32; ++s) { bs += f[s]; const float w = kf[s] * __builtin_amdgcn_exp2f(tot - bs); *(bf16_t*)(wrow + s * 2) = f2bf(w); }
        } else {
            float bs = half ? 0.f : other;
#pragma unroll
            for (int s = 31; s >= 0; --s) { bs += f[s]; const float w = kf[s] * __builtin_amdgcn_exp2f(tot - bs); *(bf16_t*)(wrow + s * 2) = f2bf(w); }
        }
        if (half == 0) DEC[((size_t)((b * 8 + h) * 2 + dir) * NCHK + ci) * 128 + k] = __builtin_amdgcn_exp2f(tot);
    }
    __syncthreads();
    bf16x8 vf[2];
#pragma unroll
    for (int ks = 0; ks < 2; ++ks) {
        const s16x4 v0 = __builtin_amdgcn_ds_read_tr16_b64_v4i16((LAS s16x4*)(Vs + (32 * ks + 8 * g + (lq >> 2)) * 272 + (16 * wid + 4 * (lq & 3)) * 2));
        const s16x4 v1 = __builtin_amdgcn_ds_read_tr16_b64_v4i16((LAS s16x4*)(Vs + (32 * ks + 8 * g + 4 + (lq >> 2)) * 272 + (16 * wid + 4 * (lq & 3)) * 2));
        vf[ks] = (bf16x8){v0[0], v0[1], v0[2], v0[3], v1[0], v1[1], v1[2], v1[3]};
    }
#pragma unroll
    for (int dir = 0; dir < 2; ++dir) {
        bf16_t* up = U + (((size_t)((b * 8 + h) * 2 + dir) * NCHK + ci) * 128 + 16 * wid + lq) * 128 + 4 * g;
#pragma unroll
        for (int kt = 0; kt < 8; ++kt) {
            f32x4 a = (f32x4){0.f, 0.f, 0.f, 0.f};
#pragma unroll
            for (int ks = 0; ks < 2; ++ks) { const bf16x8 wf = *(const bf16x8*)(WT + (dir * 128 + 16 * kt + lq) * 144 + (32 * ks + 8 * g) * 2); a = __builtin_amdgcn_mfma_f32_16x16x32_bf16(wf, vf[ks], a, 0, 0, 0); }
            u32x2 w; w.x = cvt_pk(a[0], a[1]); w.y = cvt_pk(a[2], a[3]); *(u32x2*)(up + 16 * kt) = w;
        }
    }
}
__device__ __forceinline__ void hgrn_b_phase(const bf16_t* __restrict__ U, const float* __restrict__ DEC, bf16_t* __restrict__ Sb, const int wid0) {
    for (int idx = blockIdx.x * 512 + opaque_tid(wid0); idx < 64 * 2048; idx += gridDim.x * 512) {
        const int seq = idx >> 11, rem = idx & 2047, v = rem >> 4, k8 = rem & 15, dir = seq & 1;
        float st[8];
#pragma unroll
        for (int j = 0; j < 8; ++j) st[j] = 0.f;
#pragma unroll 4
        for (int p = 0; p < NCHK; ++p) {
            const int ci = dir == 0 ? (p < 4 ? 64 + p : p - 4) : (p < 4 ? 67 - p : 67 - p);
            const size_t cb = (size_t)seq * NCHK + ci, off = (cb * 128 + v) * 128 + k8 * 8;
            const u32x4 u = *(const u32x4*)(U + off);
            const f32x4 d0 = *(const f32x4*)(DEC + cb * 128 + k8 * 8), d1 = *(const f32x4*)(DEC + cb * 128 + k8 * 8 + 4);
            u32x4 sw; sw.x = cvt_pk(st[0], st[1]); sw.y = cvt_pk(st[2], st[3]); sw.z = cvt_pk(st[4], st[5]); sw.w = cvt_pk(st[6], st[7]);
            *(u32x4*)(Sb + off) = sw;
            st[0] = d0[0] * st[0] + bflo(u.x); st[1] = d0[1] * st[1] + bfhi(u.x); st[2] = d0[2] * st[2] + bflo(u.y); st[3] = d0[3] * st[3] + bfhi(u.y);
            st[4] = d1[0] * st[4] + bflo(u.z); st[5] = d1[1] * st[5] + bfhi(u.z); st[6] = d1[2] * st[6] + bflo(u.w); st[7] = d1[3] * st[7] + bfhi(u.w);
        }
    }
}
__device__ __forceinline__ void hgrn_c_item(char* lds, const bf16_t* __restrict__ P, const float* __restrict__ lbl, const bf16_t* __restrict__ Sb, const float* __restrict__ gain, unsigned char* __restrict__ cat, int b, int h, int ci, const int wid0) {
    const int tid = opaque_tid(wid0), wid = tid >> 6, lane = tid & 63, lq = lane & 15, g = lane >> 4;
    const size_t r0 = chunk_row0(b, ci);
    char* QD = lds; char* QA = lds + 34816; char* KA = lds + 69632; char* ATT = lds + 104448; char* Vs = lds + 122880; float* SSW = (float*)(lds + 140288);
    __syncthreads();
    {
        const int r = tid >> 3, c = (tid & 7) * 16;
        const bf16_t* vp = P + (r0 + r) * EVEN_IN + 1024 + h * 128 + c;
        *(bf16x8*)(Vs + r * 272 + c * 2) = *(const bf16x8*)vp; *(bf16x8*)(Vs + r * 272 + c * 2 + 16) = *(const bf16x8*)(vp + 8);
    }
    {
        const int dir = tid >> 8, k = (tid >> 1) & 127, half = tid & 1, kk = h * 128 + k, s0 = half * 32;
        const float lb = hgrn_lb(lbl, kk);
        const bf16_t* fp = P + (r0 + s0) * EVEN_IN + (dir ? 3072 : 2048) + kk;
        const bf16_t* qp = P + (r0 + s0) * EVEN_IN + kk;
        float f[32], kf[32], q[32];
#pragma unroll
        for (int s = 0; s < 32; ++s) { f[s] = bf2f(fp[(size_t)s * EVEN_IN]); q[s] = bf2f(qp[(size_t)s * EVEN_IN]); }
        float mine = 0.f;
#pragma unroll
        for (int s = 0; s < 32; ++s) { const float g = lb + (1.0f - lb) * sigmoidf_(f[s]); kf[s] = 1.0f - g; f[s] = __builtin_amdgcn_logf(g); q[s] = siluf_(q[s]); mine += f[s]; }
        const float other = __shfl_xor(mine, 1);
        char* qd = QD + dir * 17408 + s0 * 272 + k * 2; char* qa = QA + dir * 17408 + s0 * 272 + k * 2; char* ka = KA + dir * 17408 + s0 * 272 + k * 2;
        if (dir == 0) {
            const float bm = half ? other : mine, ebm = __builtin_amdgcn_exp2f(bm); float bs = half ? other : 0.f;
#pragma unroll
            for (int s = 0; s < 32; ++s) { bs += f[s]; const float qe = q[s] * __builtin_amdgcn_exp2f(bs - bm);
                *(bf16_t*)(qd + s * 272) = f2bf(qe * ebm); *(bf16_t*)(qa + s * 272) = f2bf(qe); *(bf16_t*)(ka + s * 272) = f2bf(kf[s] * __builtin_amdgcn_exp2f(bm - bs)); }
        } else {
            const float bm = half ? mine : other, ebm = __builtin_amdgcn_exp2f(bm); float bs = half ? 0.f : other;
#pragma unroll
            for (int s = 31; s >= 0; --s) { bs += f[s]; const float qe = q[s] * __builtin_amdgcn_exp2f(bs - bm);
                *(bf16_t*)(qd + s * 272) = f2bf(qe * ebm); *(bf16_t*)(qa + s * 272) = f2bf(qe); *(bf16_t*)(ka + s * 272) = f2bf(kf[s] * __builtin_amdgcn_exp2f(bm - bs)); }
        }
    }
    __syncthreads();
    {
        const int dir = wid >> 2, tt = wid & 3;
        bf16x8 af[4];
#pragma unroll
        for (int ks = 0; ks < 4; ++ks) af[ks] = *(const bf16x8*)(QA + dir * 17408 + (16 * tt + lq) * 272 + (32 * ks + 8 * g) * 2);
#pragma unroll
        for (int stl = 0; stl < 4; ++stl) {
            f32x4 a = (f32x4){0.f, 0.f, 0.f, 0.f};
            const bool skip = dir == 0 ? (stl > tt) : (stl < tt);
            if (!skip) {
#pragma unroll
                for (int ks = 0; ks < 4; ++ks) { const bf16x8 kf = *(const bf16x8*)(KA + dir * 17408 + (16 * stl + lq) * 272 + (32 * ks + 8 * g) * 2); a = __builtin_amdgcn_mfma_f32_16x16x32_bf16(af[ks], kf, a, 0, 0, 0); }
            }
            const int s = 16 * stl + lq;
#pragma unroll
            for (int i = 0; i < 4; ++i) { const int t = 16 * tt + 4 * g + i; const bool keep = !skip && (dir == 0 ? (s <= t) : (s >= t));
                *(bf16_t*)(ATT + dir * 9216 + t * 144 + s * 2) = keep ? f2bf(a[i]) : (bf16_t)0; }
        }
    }
    __syncthreads();
    f32x4 o[4];
#pragma unroll
    for (int tt = 0; tt < 4; ++tt) o[tt] = (f32x4){0.f, 0.f, 0.f, 0.f};
    bf16x8 vf[2];
#pragma unroll
    for (int ks = 0; ks < 2; ++ks) {
        const s16x4 v0 = __builtin_amdgcn_ds_read_tr16_b64_v4i16((LAS s16x4*)(Vs + (32 * ks + 8 * g + (lq >> 2)) * 272 + (16 * wid + 4 * (lq & 3)) * 2));
        const s16x4 v1 = __builtin_amdgcn_ds_read_tr16_b64_v4i16((LAS s16x4*)(Vs + (32 * ks + 8 * g + 4 + (lq >> 2)) * 272 + (16 * wid + 4 * (lq & 3)) * 2));
        vf[ks] = (bf16x8){v0[0], v0[1], v0[2], v0[3], v1[0], v1[1], v1[2], v1[3]};
    }
#pragma unroll
    for (int dir = 0; dir < 2; ++dir) {
        const bf16_t* sp = Sb + (((size_t)((b * 8 + h) * 2 + dir) * NCHK + ci) * 128 + 16 * wid + lq) * 128 + 8 * g;
        bf16x8 sf[4];
#pragma unroll
        for (int ks = 0; ks < 4; ++ks) sf[ks] = *(const bf16x8*)(sp + 32 * ks);
#pragma unroll
        for (int tt = 0; tt < 4; ++tt) {
#pragma unroll
            for (int ks = 0; ks < 4; ++ks) { const bf16x8 qf = *(const bf16x8*)(QD + dir * 17408 + (16 * tt + lq) * 272 + (32 * ks + 8 * g) * 2); o[tt] = __builtin_amdgcn_mfma_f32_16x16x32_bf16(qf, sf[ks], o[tt], 0, 0, 0); }
#pragma unroll
            for (int ks = 0; ks < 2; ++ks) { const bf16x8 pf = *(const bf16x8*)(ATT + dir * 9216 + (16 * tt + lq) * 144 + (32 * ks + 8 * g) * 2); o[tt] = __builtin_amdgcn_mfma_f32_16x16x32_bf16(pf, vf[ks], o[tt], 0, 0, 0); }
        }
    }
#pragma unroll
    for (int tt = 0; tt < 4; ++tt)
#pragma unroll
        for (int i = 0; i < 4; ++i) { float p = o[tt][i] * o[tt][i]; p += __shfl_xor(p, 1); p += __shfl_xor(p, 2); p += __shfl_xor(p, 4); p += __shfl_xor(p, 8);
            if (lq == 0) SSW[wid * 64 + 16 * tt + 4 * g + i] = p; }
    __syncthreads();
    const float gn = gain[16 * wid + lq];
#pragma unroll
    for (int tt = 0; tt < 4; ++tt)
#pragma unroll
        for (int i = 0; i < 4; ++i) { const int t = 16 * tt + 4 * g + i; float ss = 0.f;
#pragma unroll
            for (int w = 0; w < 8; ++w) ss += SSW[w * 64 + t];
            const float rstd = rsqrtf(ss * (1.0f / 128.0f) + EPS);
            const size_t row = r0 + t; const float graw = bf2f(P[row * EVEN_IN + 4096 + h * 128 + 16 * wid + lq]);
            cat[row * D + h * 128 + 16 * wid + lq] = f2fp8(o[tt][i] * rstd * gn * siluf_(graw)); }
}

__device__ __forceinline__ void norm_mod_rows(const float* __restrict__ src_lat, const float* __restrict__ src_ctx, int nrows, const float* __restrict__ gain,
                                              const float* __restrict__ mods_l, int sh_chunk, int sc_chunk, unsigned char* __restrict__ H, int gw, int NGW, int lane) {
    for (int r = gw; r < nrows; r += NGW) {
        const float* xr = r < TL ? src_lat + (size_t)r * D : src_ctx + (size_t)(r - TL) * D; const int rt = r < TL ? (r >> 12) : 4;
        f32x4 v[8]; float ss = 0.f;
#pragma unroll
        for (int j = 0; j < 8; ++j) { v[j] = *(const f32x4*)(xr + 4 * lane + 256 * j); ss += (v[j][0] * v[j][0] + v[j][1] * v[j][1]) + (v[j][2] * v[j][2] + v[j][3] * v[j][3]); }
        const float rstd = rsqrtf(wave_sum(ss) * (1.0f / D) + EPS);
        const float* mp = mods_l + (size_t)rt * MODW;
#pragma unroll
        for (int j = 0; j < 8; ++j) { const int col = 4 * lane + 256 * j;
            const f32x4 gg = *(const f32x4*)(gain + col), sc = *(const f32x4*)(mp + sc_chunk * D + col), sh = *(const f32x4*)(mp + sh_chunk * D + col);
            const f32x4 y = v[j] * rstd * gg * (sc + 1.0f) + sh;
            int w = 0; w = __builtin_amdgcn_cvt_pk_fp8_f32(y[0], y[1], w, false); w = __builtin_amdgcn_cvt_pk_fp8_f32(y[2], y[3], w, true); *(int*)(H + (size_t)r * D + col) = w; }
    }
}
__device__ __forceinline__ void norm2_router(int nrows, const bf16_t* __restrict__ x1, const float* __restrict__ gain, const float* __restrict__ mods_l, unsigned char* __restrict__ H8,
                                             const bf16_t* __restrict__ wrhi, const bf16_t* __restrict__ wrlo, const float* __restrict__ brt, unsigned* cnt, int* __restrict__ list, float* __restrict__ wts, int* __restrict__ sloti,
                                             char* lds, int vcu, int G, int wid, int lane) {
    const int lq = lane & 15, g = lane >> 4;
    float* ssp = (float*)lds;
    float* plog = (float*)(lds + 1024);
    const float bias = brt[lane];
    for (int tile = vcu; tile < nrows / 32; tile += G) {
        const int row0 = tile * 32; const int rt = row0 < TL ? (row0 >> 12) : 4;
        const int kbase = wid * 256 + 8 * g;
        float ssq[2];
#pragma unroll
        for (int mt = 0; mt < 2; ++mt) { const bf16_t* xr = x1 + (size_t)(row0 + 16 * mt + lq) * D + kbase; float a = 0.f;
#pragma unroll
            for (int ks = 0; ks < 8; ++ks) { const u32x4 w = *(const u32x4*)(xr + 32 * ks);
                const float u0 = bflo(w.x), u1 = bfhi(w.x), u2 = bflo(w.y), u3 = bfhi(w.y), u4 = bflo(w.z), u5 = bfhi(w.z), u6 = bflo(w.w), u7 = bfhi(w.w);
                a += (u0 * u0 + u1 * u1) + (u2 * u2 + u3 * u3) + (u4 * u4 + u5 * u5) + (u6 * u6 + u7 * u7); }
            a += __shfl_xor(a, 16); a += __shfl_xor(a, 32); ssq[mt] = a; }
        __syncthreads();
        if (g == 0) { ssp[wid * 32 + lq] = ssq[0]; ssp[wid * 32 + 16 + lq] = ssq[1]; }
        __syncthreads();
        float rstd[2];
#pragma unroll
        for (int mt = 0; mt < 2; ++mt) { float t = 0.f;
#pragma unroll
            for (int w = 0; w < 8; ++w) t += ssp[w * 32 + 16 * mt + lq];
            rstd[mt] = rsqrtf(t * (1.0f / D) + EPS); }
        const float* mp = mods_l + (size_t)rt * MODW;
        f32x4 acc[2][4];
#pragma unroll
        for (int mt = 0; mt < 2; ++mt)
#pragma unroll
            for (int et = 0; et < 4; ++et) acc[mt][et] = (f32x4){0.f, 0.f, 0.f, 0.f};
#pragma unroll 2
        for (int ks = 0; ks < 8; ++ks) {
            const int col = kbase + 32 * ks;
            f32x4 ga[2], sa[2], ha[2];
#pragma unroll
            for (int q = 0; q < 2; ++q) { ga[q] = *(const f32x4*)(gain + col + 4 * q); sa[q] = *(const f32x4*)(mp + 4 * D + col + 4 * q) + 1.0f; ha[q] = *(const f32x4*)(mp + 3 * D + col + 4 * q); }
            bf16x8 whi[4], wlo[4];
#pragma unroll
            for (int et = 0; et < 4; ++et) { whi[et] = *(const bf16x8*)(wrhi + (size_t)(16 * et + lq) * D + col); wlo[et] = *(const bf16x8*)(wrlo + (size_t)(16 * et + lq) * D + col); }
#pragma unroll
            for (int mt = 0; mt < 2; ++mt) {
                float hv[8]; const u32x4 xw = *(const u32x4*)(x1 + (size_t)(row0 + 16 * mt + lq) * D + col);
#pragma unroll
                for (int q = 0; q < 2; ++q) { const f32x4 xq = q == 0 ? (f32x4){bflo(xw.x), bfhi(xw.x), bflo(xw.y), bfhi(xw.y)} : (f32x4){bflo(xw.z), bfhi(xw.z), bflo(xw.w), bfhi(xw.w)}; const f32x4 y = xq * rstd[mt] * ga[q] * sa[q] + ha[q]; hv[4 * q] = y[0]; hv[4 * q + 1] = y[1]; hv[4 * q + 2] = y[2]; hv[4 * q + 3] = y[3]; }
                { int w0 = 0, w1 = 0; w0 = __builtin_amdgcn_cvt_pk_fp8_f32(hv[0], hv[1], w0, false); w0 = __builtin_amdgcn_cvt_pk_fp8_f32(hv[2], hv[3], w0, true);
                  w1 = __builtin_amdgcn_cvt_pk_fp8_f32(hv[4], hv[5], w1, false); w1 = __builtin_amdgcn_cvt_pk_fp8_f32(hv[6], hv[7], w1, true);
                  u32x2 h8; h8.x = (unsigned)w0; h8.y = (unsigned)w1; *(u32x2*)(H8 + (size_t)(row0 + 16 * mt + lq) * D + col) = h8; }
                u32x4 hw; hw.x = cvt_pk(hv[0], hv[1]); hw.y = cvt_pk(hv[2], hv[3]); hw.z = cvt_pk(hv[4], hv[5]); hw.w = cvt_pk(hv[6], hv[7]);
                u32x4 lw; lw.x = cvt_pk(hv[0] - bflo(hw.x), hv[1] - bfhi(hw.x)); lw.y = cvt_pk(hv[2] - bflo(hw.y), hv[3] - bfhi(hw.y));
                lw.z = cvt_pk(hv[4] - bflo(hw.z), hv[5] - bfhi(hw.z)); lw.w = cvt_pk(hv[6] - bflo(hw.w), hv[7] - bfhi(hw.w));
                const bf16x8 hf = *reinterpret_cast<bf16x8*>(&hw), lf = *reinterpret_cast<bf16x8*>(&lw);
#pragma unroll
                for (int et = 0; et < 4; ++et) {
                    acc[mt][et] = __builtin_amdgcn_mfma_f32_16x16x32_bf16(hf, whi[et], acc[mt][et], 0, 0, 0);
                    acc[mt][et] = __builtin_amdgcn_mfma_f32_16x16x32_bf16(lf, whi[et], acc[mt][et], 0, 0, 0);
                    acc[mt][et] = __builtin_amdgcn_mfma_f32_16x16x32_bf16(hf, wlo[et], acc[mt][et], 0, 0, 0); }
            }
        }
#pragma unroll
        for (int mt = 0; mt < 2; ++mt)
#pragma unroll
            for (int et = 0; et < 4; ++et)
#pragma unroll
                for (int i = 0; i < 4; ++i) plog[(wid * 32 + 16 * mt + 4 * g + i) * 64 + 16 * et + lq] = acc[mt][et][i];
        __syncthreads();
        float tot[4];
#pragma unroll
        for (int j = 0; j < 4; ++j) { const int idx = (wid * 64 + lane) * 4 + j; float sm = 0.f;
#pragma unroll
            for (int w = 0; w < 8; ++w) sm += plog[w * 2048 + idx];
            tot[j] = sm; }
        __syncthreads();
#pragma unroll
        for (int j = 0; j < 4; ++j) plog[(wid * 64 + lane) * 4 + j] = tot[j];
        __syncthreads();
        {
            float s4[4], cand4[4], w4[4]; int myk4[4];
#pragma unroll
            for (int rr = 0; rr < 4; ++rr) {
                const float logit = plog[(wid * 4 + rr) * 64 + lane];
                const float sg = 1.0f / (1.0f + expf(-logit)), bsd = sg + bias;
                float m1 = bsd; m1 = fmaxf(m1, __shfl_xor(m1, 1)); m1 = fmaxf(m1, __shfl_xor(m1, 2)); m1 = fmaxf(m1, __shfl_xor(m1, 4));
                const unsigned long long bal = __ballot(bsd == m1); const int gbase = lane & ~7; const unsigned gb = (unsigned)(bal >> gbase) & 0xffu; const int first = gbase + __ffs(gb) - 1;
                float m2 = (lane == first) ? -INFINITY : bsd; m2 = fmaxf(m2, __shfl_xor(m2, 1)); m2 = fmaxf(m2, __shfl_xor(m2, 2)); m2 = fmaxf(m2, __shfl_xor(m2, 4));
                const float gs = m1 + m2; int rank = 0;
#pragma unroll
                for (int j = 0; j < 8; ++j) { const float gj = __shfl(gs, 8 * j); rank += (gj > gs || (gj == gs && j < (lane >> 3))) ? 1 : 0; }
                s4[rr] = sg; cand4[rr] = rank < 4 ? bsd : -INFINITY; myk4[rr] = -1; }
#pragma unroll
            for (int k = 0; k < 8; ++k)
#pragma unroll
                for (int rr = 0; rr < 4; ++rr) { float mm = cand4[rr];
#pragma unroll
                    for (int o = 1; o < 64; o <<= 1) mm = fmaxf(mm, __shfl_xor(mm, o));
                    const unsigned long long bb = __ballot(cand4[rr] == mm); const int win = __ffsll((long long)bb) - 1;
                    if (lane == win) { myk4[rr] = k; cand4[rr] = -INFINITY; } }
#pragma unroll
            for (int rr = 0; rr < 4; ++rr) { const float wsum = wave_sum(myk4[rr] >= 0 ? s4[rr] : 0.f); w4[rr] = s4[rr] / wsum * 2.5f; }
            unsigned pos4[4];
#pragma unroll
            for (int rr = 0; rr < 4; ++rr) pos4[rr] = myk4[rr] >= 0 ? atomicAdd(cnt + lane * 64, 1u) : 0u;
#pragma unroll
            for (int rr = 0; rr < 4; ++rr) if (myk4[rr] >= 0) { const int rloc = wid * 4 + rr, aid = (row0 + rloc) * 8 + myk4[rr];
                list[(size_t)lane * TA + pos4[rr]] = row0 + rloc; sloti[aid] = (lane << 20) | (int)pos4[rr]; wts[aid] = w4[rr]; }
        }
    }
}
__device__ __forceinline__ void combine_rows(int nrows, bf16_t* __restrict__ x1, const unsigned char* __restrict__ Y, const float* __restrict__ wts, const int* __restrict__ sloti, const int* tstart, const float* __restrict__ mods_l,
                                             const float* __restrict__ gain_n, const float* __restrict__ mods_n, unsigned char* __restrict__ H, float* __restrict__ outp, int gw, int NGW, int lane) {
    for (int r = gw; r < nrows; r += NGW) {
        const int rt = r < TL ? (r >> 12) : 4;
        float acc[4][8];
#pragma unroll
        for (int j = 0; j < 4; ++j)
#pragma unroll
            for (int e = 0; e < 8; ++e) acc[j][e] = 0.f;
        int myrow; float myw;
        { const int kq = lane & 7; const int info = sloti[(size_t)r * 8 + kq]; myrow = tstart[info >> 20] * 256 + (info & 0xfffff); myw = wts[(size_t)r * 8 + kq]; }
#pragma unroll 3
        for (int k = 0; k < 9; ++k) { const size_t srow = k < 8 ? (size_t)__shfl(myrow, k) : (size_t)tstart[64] * 256 + r; const float w = k < 8 ? __shfl(myw, k) : 1.0f;
#pragma unroll
            for (int j = 0; j < 4; ++j) { const u32x2 v = *(const u32x2*)(Y + srow * D + 8 * lane + 512 * j);
                const f32x2 a0 = __builtin_amdgcn_cvt_pk_f32_fp8((int)v.x, false), a1 = __builtin_amdgcn_cvt_pk_f32_fp8((int)v.x, true), a2 = __builtin_amdgcn_cvt_pk_f32_fp8((int)v.y, false), a3 = __builtin_amdgcn_cvt_pk_f32_fp8((int)v.y, true);
                acc[j][0] += w * a0[0]; acc[j][1] += w * a0[1]; acc[j][2] += w * a1[0]; acc[j][3] += w * a1[1]; acc[j][4] += w * a2[0]; acc[j][5] += w * a2[1]; acc[j][6] += w * a3[0]; acc[j][7] += w * a3[1]; } }
        float ss = 0.f; const float* mp = mods_l + (size_t)rt * MODW + 5 * D;
#pragma unroll
        for (int j = 0; j < 4; ++j) { const int col = 8 * lane + 512 * j; bf16_t* xp = x1 + (size_t)r * D + col;
            const u32x4 xw = *(const u32x4*)xp; const float xv[8] = {bflo(xw.x), bfhi(xw.x), bflo(xw.y), bfhi(xw.y), bflo(xw.z), bfhi(xw.z), bflo(xw.w), bfhi(xw.w)};
            const f32x4 g2a = *(const f32x4*)(mp + col), g2b = *(const f32x4*)(mp + col + 4);
#pragma unroll
            for (int e = 0; e < 8; ++e) { const float y = xv[e] + (e < 4 ? g2a[e & 3] : g2b[e & 3]) * acc[j][e]; acc[j][e] = y; ss += y * y; }
            if (!outp) { u32x4 o; o.x = cvt_pk(acc[j][0], acc[j][1]); o.y = cvt_pk(acc[j][2], acc[j][3]); o.z = cvt_pk(acc[j][4], acc[j][5]); o.w = cvt_pk(acc[j][6], acc[j][7]); *(u32x4*)xp = o; } }
        const float rstd = rsqrtf(wave_sum(ss) * (1.0f / D) + EPS);
        if (outp) {
#pragma unroll
            for (int j = 0; j < 4; ++j)
#pragma unroll
                for (int q = 0; q < 2; ++q) { const int col = 8 * lane + 512 * j + 4 * q; const f32x4 gg = *(const f32x4*)(gain_n + col); f32x4 y;
#pragma unroll
                    for (int e = 0; e < 4; ++e) y[e] = acc[j][4 * q + e] * rstd * gg[e];
                    *(f32x4*)(outp + (size_t)r * D + col) = y; }
        } else {
            const float* mn = mods_n + (size_t)rt * MODW;
#pragma unroll
            for (int j = 0; j < 4; ++j) { const int col = 8 * lane + 512 * j; float y[8];
#pragma unroll
                for (int q = 0; q < 2; ++q) { const f32x4 gg = *(const f32x4*)(gain_n + col + 4 * q), sc = *(const f32x4*)(mn + 1 * D + col + 4 * q), sh = *(const f32x4*)(mn + col + 4 * q);
#pragma unroll
                    for (int e = 0; e < 4; ++e) y[4 * q + e] = acc[j][4 * q + e] * rstd * gg[e] * (1.0f + sc[e]) + sh[e]; }
                int w0 = 0, w1 = 0; w0 = __builtin_amdgcn_cvt_pk_fp8_f32(y[0], y[1], w0, false); w0 = __builtin_amdgcn_cvt_pk_fp8_f32(y[2], y[3], w0, true); w1 = __builtin_amdgcn_cvt_pk_fp8_f32(y[4], y[5], w1, false); w1 = __builtin_amdgcn_cvt_pk_fp8_f32(y[6], y[7], w1, true);
                u32x2 w; w.x = (unsigned)w0; w.y = (unsigned)w1; *(u32x2*)(H + (size_t)r * D + col) = w; }
        }
    }
}
__device__ __forceinline__ void rope_norm32(const bf16_t* __restrict__ src, unsigned char* __restrict__ dst8, int krow, const float* __restrict__ gn, const float* __restrict__ tab, int lane4, bool rope, int posr, int posc) {
    u32x4 w[4]; float x[32]; float ss = 0.f;
#pragma unroll
    for (int j = 0; j < 4; ++j) { w[j] = *(const u32x4*)(src + 8 * j);
        x[8 * j] = bflo(w[j].x); x[8 * j + 1] = bfhi(w[j].x); x[8 * j + 2] = bflo(w[j].y); x[8 * j + 3] = bfhi(w[j].y); x[8 * j + 4] = bflo(w[j].z); x[8 * j + 5] = bfhi(w[j].z); x[8 * j + 6] = bflo(w[j].w); x[8 * j + 7] = bfhi(w[j].w); }
#pragma unroll
    for (int e = 0; e < 32; ++e) ss += x[e] * x[e];
    ss += __shfl_xor(ss, 1); ss += __shfl_xor(ss, 2);
    const float rstd = rsqrtf(ss * (1.0f / 128.0f) + EPS);
    const int p0 = lane4 * 32, hf = p0 >> 6; const int pos = hf ? posc : posr;
#pragma unroll
    for (int e = 0; e < 32; e += 2) { const int j = ((p0 + e) & 63) >> 1;
        const float y1 = x[e] * rstd * gn[64 * hf + j], y2 = x[e + 1] * rstd * gn[64 * hf + 32 + j];
        float c = 1.f, s = 0.f; if (rope) { c = tab[pos * 32 + j]; s = tab[2048 + pos * 32 + j]; }
        x[e] = y1 * c - y2 * s; x[e + 1] = y2 * c + y1 * s; }
#pragma unroll
    for (int j = 0; j < 4; ++j) { const int p = p0 + 8 * j, byte = ((p >> 3) & 1) * 64 + (p >> 4) * 8;
        int wa = 0, wb = 0; wa = __builtin_amdgcn_cvt_pk_fp8_f32(x[8 * j], x[8 * j + 1], wa, false); wa = __builtin_amdgcn_cvt_pk_fp8_f32(x[8 * j + 2], x[8 * j + 3], wa, true);
        wb = __builtin_amdgcn_cvt_pk_fp8_f32(x[8 * j + 4], x[8 * j + 5], wb, false); wb = __builtin_amdgcn_cvt_pk_fp8_f32(x[8 * j + 6], x[8 * j + 7], wb, true);
        u32x2 o; o.x = (unsigned)wa; o.y = (unsigned)wb; *(u32x2*)(dst8 + ga::k8_off(krow, byte >> 4) + (byte & 15)) = o; }
}
__device__ __forceinline__ void post_odd(const bf16_t* __restrict__ PO, const float* __restrict__ gk, const float* __restrict__ tab,
                                         unsigned char* __restrict__ K8, unsigned char* __restrict__ VT8, char* lds, int vcu, int G, int gw, int NGW, int tid, int lane) {
    const int l32 = lane & 31;
    for (int r = 2 * gw + (lane >> 5); r < TA; r += 2 * NGW) {
        const bool lat = r < TL; int b, kp, posr = 0, posc = 0;
        if (lat) { b = r >> 12; const int t = r & (SEQ - 1); kp = CTXL + t; posr = t >> 6; posc = t & 63; } else { b = (r - TL) >> 8; kp = (r - TL) & (CTXL - 1); }
        const bf16_t* pr = PO + (size_t)r * ODD_IN;
        if (l32 < 16) rope_norm32(pr + 2048 + 32 * l32, K8 + (size_t)(((b * 4 + (l32 >> 2)) * 68) + (kp >> 6)) * 8192, kp & 63, gk, tab, l32 & 3, lat, posr, posc);
    }
    for (int tl = vcu; tl < NBATCH * 4 * 68; tl += G) {
        const int t68 = tl % 68, kvh = (tl / 68) & 3, b = tl / (68 * 4);
        const int k = tid >> 3, c = (tid & 7) * 16, kp = 64 * t68 + k;
        const size_t row = kp < CTXL ? (size_t)(TL + b * CTXL + kp) : (size_t)(b * SEQ + kp - CTXL);
        const bf16_t* vp = PO + row * ODD_IN + 2560 + kvh * 128 + c;
        const u32x2 f0 = ga::k8pack(*(const bf16x8*)vp), f1 = ga::k8pack(*(const bf16x8*)(vp + 8));
        __syncthreads();
        const int pos = ga::vt_pos(k);
#pragma unroll
        for (int e = 0; e < 16; ++e) { const unsigned w = e < 4 ? f0.x : e < 8 ? f0.y : e < 12 ? f1.x : f1.y; lds[ga::vt_off(c + e, pos)] = (char)((w >> (8 * (e & 3))) & 0xff); }
        __syncthreads();
        *(u32x4*)(VT8 + (size_t)tl * 8192 + tid * 16) = *(const u32x4*)(lds + tid * 16);
    }
}

__device__ __forceinline__ int dest_row(int n, int map) {
    if (map == 0) return n;
    if (map == 1) return (n >> 7) * 256 + (n & 127);
    if (map == 2) return (n >> 7) * 256 + 128 + (n & 127);
    if (n >= 2560) return n;
    const int head = n >> 7, i = n & 127, hf = i >> 6, ii = i & 63, part = ii >> 5, j = ii & 31;
    return head * 128 + hf * 64 + 2 * j + part;
}
struct TItem { const float* src; unsigned char* dst; int ldw, K, map, fp8; float scale; };
__device__ __forceinline__ void titem_load(const TItem& t, f32x4 (&v)[8], int lane) {
#pragma unroll
    for (int i = 0; i < 8; ++i) v[i] = __builtin_nontemporal_load((const f32x4*)(t.src + (size_t)(8 * (lane >> 3) + i) * t.ldw + 4 * (lane & 7)));
}
__device__ __forceinline__ void titem_store(const TItem& t, const f32x4 (&v)[8], int n0, int lane) {
    const int kq = 8 * (lane >> 3);
#pragma unroll
    for (int e = 0; e < 4; ++e) { const size_t drow = (size_t)dest_row(n0 + 4 * (lane & 7) + e, t.map);
        if (t.fp8) { int w0 = 0, w1 = 0;
            w0 = __builtin_amdgcn_cvt_pk_fp8_f32(v[0][e] * t.scale, v[1][e] * t.scale, w0, false); w0 = __builtin_amdgcn_cvt_pk_fp8_f32(v[2][e] * t.scale, v[3][e] * t.scale, w0, true);
            w1 = __builtin_amdgcn_cvt_pk_fp8_f32(v[4][e] * t.scale, v[5][e] * t.scale, w1, false); w1 = __builtin_amdgcn_cvt_pk_fp8_f32(v[6][e] * t.scale, v[7][e] * t.scale, w1, true);
            u32x2 o; o.x = (unsigned)w0; o.y = (unsigned)w1; *(u32x2*)(t.dst + drow * t.K + kq) = o;
        } else { u32x4 o; o.x = cvt_pk(v[0][e], v[1][e]); o.y = cvt_pk(v[2][e], v[3][e]); o.z = cvt_pk(v[4][e], v[5][e]); o.w = cvt_pk(v[6][e], v[7][e]); *(u32x4*)(t.dst + (drow * t.K + kq) * 2) = o; }
    }
}

struct Args { const float* in[26]; float* out; unsigned char* ws; int ph_lo, ph_hi; };
constexpr int NPHASE = 19;
#ifndef PHMASK
#define PHMASK 0xFFFFFFFFu
#endif
#define SITE(n) ((PHMASK >> (n)) & 1u)
__device__ __forceinline__ unsigned char* opq(unsigned char* p) { asm volatile("" : "+s"(p)); return p; }
__device__ __forceinline__ const float* opq(const float* p) { asm volatile("" : "+s"(p)); return p; }
__device__ __forceinline__ int opqi(int v) { asm volatile("" : "+s"(v)); return v; }
#define CAS __attribute__((address_space(4)))
__device__ __forceinline__ const CAS unsigned char* kargs() { const CAS unsigned char* p = (const CAS unsigned char*)__builtin_amdgcn_kernarg_segment_ptr(); asm volatile("" : "+s"(p)); return p; }
static_assert(sizeof(Args) == 232 && offsetof(Args, out) == 208 && offsetof(Args, ws) == 216 && offsetof(Args, ph_lo) == 224, "Args layout");
#define INP(k) (*(const float* const CAS*)(kargs() + 8 * (k)))
#define OUTP() (*(float* const CAS*)(kargs() + 208))
#define WSP(T, off) ((T*)(*(unsigned char* const CAS*)(kargs() + 216) + (off)))
#define PH_LO() (*(const int CAS*)(kargs() + 224))
#define PH_HI() (*(const int CAS*)(kargs() + 228))
#define IN(k) (PH_LO() <= (k) && (k) < PH_HI())

constexpr int T_ND = 13568, T_NX1 = 195 * 512;
#define TDESC(it_, t_, n0_) do { const int it__ = (it_); int kb_, nb_; \
        if (it__ < 6400) { kb_ = it__ / 200; nb_ = it__ % 200; t_.src = INP(8); t_.ldw = EVEN_IN; t_.K = D; t_.dst = WSP(unsigned char, WS_WINE); t_.map = 0; t_.fp8 = 1; t_.scale = 64.f; } \
        else if (it__ < 8448) { const int r_ = it__ - 6400; kb_ = r_ / 64; nb_ = r_ % 64; t_.src = INP(9); t_.ldw = D; t_.K = D; t_.dst = WSP(unsigned char, WS_WOUTE); t_.map = 0; t_.fp8 = 1; t_.scale = 64.f; } \
        else if (it__ < 11520) { const int r_ = it__ - 8448; kb_ = r_ / 96; nb_ = r_ % 96; t_.src = INP(13); t_.ldw = ODD_IN; t_.K = D; t_.dst = WSP(unsigned char, WS_WINO); t_.map = 3; t_.fp8 = 1; t_.scale = 64.f; } \
        else if (it__ < T_ND) { const int r_ = it__ - 11520; kb_ = r_ / 64; nb_ = r_ % 64; t_.src = INP(14); t_.ldw = D; t_.K = D; t_.dst = WSP(unsigned char, WS_WOUTO); t_.map = 0; t_.fp8 = 1; t_.scale = 64.f; } \
        else { const int r_ = it__ - T_ND, qq_ = r_ >> 9, w_ = r_ & 511, l_ = qq_ / 195, rem_ = qq_ % 195, e_ = rem_ / 3, mat_ = rem_ % 3; t_.fp8 = 1; \
            if (mat_ < 2) { kb_ = w_ >> 4; nb_ = w_ & 15; t_.src = e_ < 64 ? (mat_ == 0 ? INP(19) : INP(20)) + ((size_t)(l_ * 64 + e_)) * D * DEXP : (mat_ == 0 ? INP(22) : INP(23)) + (size_t)l_ * D * DEXP; \
                t_.ldw = DEXP; t_.K = D; t_.dst = WSP(unsigned char, WS_WGU) + ((size_t)(l_ * 65 + e_)) * 1024 * D; t_.map = 1 + mat_; t_.scale = 64.f; } \
            else { kb_ = w_ >> 6; nb_ = w_ & 63; t_.src = e_ < 64 ? INP(21) + ((size_t)(l_ * 64 + e_)) * DEXP * D : INP(24) + (size_t)l_ * DEXP * D; \
                t_.ldw = D; t_.K = DEXP; t_.dst = WSP(unsigned char, WS_WDN) + ((size_t)(l_ * 65 + e_)) * D * DEXP; t_.map = 0; t_.scale = 32.f; } } \
        t_.src += (size_t)(64 * kb_) * t_.ldw + 32 * nb_; t_.dst += (size_t)(64 * kb_) * (t_.fp8 ? 1 : 2); n0_ = 32 * nb_; } while (0)
struct Geo { int tid, lane, wid, G, bx, vcu, gw, NGW; };
__device__ __forceinline__ Geo geo(const int wid0) { Geo g; g.tid = opaque_tid(wid0); g.lane = g.tid & 63; g.wid = __builtin_amdgcn_readfirstlane(g.tid >> 6); g.G = gridDim.x; g.bx = blockIdx.x;
    g.vcu = (g.G % 8 == 0) ? (g.bx % 8) * (g.G / 8) + g.bx / 8 : g.bx; g.gw = g.vcu * NWAVES + g.wid; g.NGW = g.G * NWAVES; return g; }

__device__ __forceinline__ void phase_prologue(const Args& args, LAS unsigned char* ldsl, char* ldsg, const int wid0) {
    const Geo q = geo(wid0); const int tid = q.tid, lane = q.lane, wid = q.wid, G = q.G, bx = q.bx;
    for (int ait = bx; ait < 192; ait += G) {
        const float* c_in = INP(1); const float* cctx_in = INP(3); const float* w_ada = INP(4); const float* b_ada = INP(5); float* mods = WSP(float, WS_MODS);
        float* sl = (float*)ldsg; float* red = (float*)(ldsg + 40960);
        for (int i = tid; i < 5 * D; i += 512) { const int r = i >> 11, k = i & (D - 1); const float cv = r < 4 ? c_in[r * D + k] : cctx_in[k]; sl[i] = cv / (1.0f + expf(-cv)); }
        __syncthreads();
        const int l = ait / 96, n0 = (ait % 96) * 128, cg = tid & 31, kg = tid >> 5;
        f32x4 acc[5];
#pragma unroll
        for (int r = 0; r < 5; ++r) acc[r] = (f32x4){0.f, 0.f, 0.f, 0.f};
        const float* wp = w_ada + ((size_t)l * D + kg * 128) * MODW + n0 + 4 * cg;
#pragma unroll 8
        for (int k = 0; k < 128; ++k) { const f32x4 w = *(const f32x4*)(wp + (size_t)k * MODW);
#pragma unroll
            for (int r = 0; r < 5; ++r) acc[r] += w * sl[r * D + kg * 128 + k]; }
#pragma unroll
        for (int r = 0; r < 5; ++r) *(f32x4*)(red + (kg * 5 + r) * 128 + 4 * cg) = acc[r];
        __syncthreads();
        if (tid < 160) { const int r = tid >> 5; f32x4 sm = *(const f32x4*)(b_ada + (size_t)l * MODW + n0 + 4 * cg);
            for (int k2 = 0; k2 < 16; ++k2) sm += *(const f32x4*)(red + (k2 * 5 + r) * 128 + 4 * cg);
            *(f32x4*)(mods + ((size_t)l * 5 + r) * MODW + n0 + 4 * cg) = sm; }
        __syncthreads();
    }
    if (bx == G - 1) {
        float* tab = WSP(float, WS_TAB);
        for (int i = tid; i < 64 * 16; i += 512) { const int pos = i >> 4, j = i & 15; const float fr = expf(-9.210340371976184f * (float)j / 16.0f), a = (float)pos * fr; tab[i] = cosf(a); tab[1024 + i] = sinf(a); }
        for (int i = tid; i < 64 * 32; i += 512) { const int pos = i >> 5, j = i & 31; const float fr = expf(-9.210340371976184f * (float)j / 32.0f), a = (float)pos * fr; tab[2048 + i] = cosf(a); tab[4096 + i] = sinf(a); }
    }
    { const float* w_router = INP(17); bf16_t* wr_hi = WSP(bf16_t, WS_WR); bf16_t* wr_lo = wr_hi + 2 * 64 * 2048;
      for (int i = bx * 512 + tid; i < 2 * 64 * 2048; i += G * 512) {
        const int l = i >> 17, e = (i >> 11) & 63, k = i & 2047; const float w = w_router[((size_t)l * D + k) * 64 + e];
        const bf16_t hi16 = f2bf(w); wr_hi[i] = hi16; wr_lo[i] = f2bf(w - bf2f(hi16)); } }
    const int NIT = (PH_HI() - PH_LO() > 1) ? T_ND : T_ND + 2 * T_NX1;
    int it = q.gw;
    if (it < NIT) {
        TItem ta, tb; int na, nb2; f32x4 va[8], vb[8];
        TDESC(it, ta, na); titem_load(ta, va, lane);
        for (;;) {
            int nx = it + q.NGW;
            if (nx < NIT) { TDESC(nx, tb, nb2); titem_load(tb, vb, lane); }
            titem_store(ta, va, na, lane);
            if (nx >= NIT) break;
            it = nx; nx = it + q.NGW;
            if (nx < NIT) { TDESC(nx, ta, na); titem_load(ta, va, lane); }
            titem_store(tb, vb, nb2, lane);
            if (nx >= NIT) break;
            it = nx;
        }
    }
    __syncthreads();
}
template <int L> __device__ __forceinline__ void phase_inproj(const Args& args, LAS unsigned char* ldsl, const int wid0) {
    pg8::DenseSched S; S.init(TA, L == 0 ? EVEN_IN : ODD_IN, D / 2, gridDim.x, blockIdx.x, WSP(unsigned char, L == 0 ? WS_WINE : WS_WINO));
    pg8::EpiProj E{WSP(bf16_t, L == 0 ? WS_PE : WS_PO), L == 0 ? EVEN_IN : ODD_IN, L == 0 ? 20 : 0, L == 0 ? 24 : 0, L == 0 ? 24 : -1, WSP(float, WS_TAB)};
    pg8::gemm_phase<pg8::EpiProj, pg8::DenseSched, true, 127 - 6, true>(ldsl, (const char*)WSP(unsigned char, WS_H), D / 2, S, E, wid0);
}
template <int L> __device__ __forceinline__ void phase_outproj(const Args& args, LAS unsigned char* ldsl, const int wid0) {
    constexpr int T = L == 0 ? TA : TL;
    pg8::DenseSched S; S.init(T, D, D / 2, gridDim.x, blockIdx.x, WSP(unsigned char, L == 0 ? WS_WOUTE : WS_WOUTO));
    pg8::EpiOutRes<L != 0> E{INP(0), INP(2), WSP(bf16_t, WS_X1), WSP(float, WS_MODS) + (size_t)L * 5 * MODW + 2 * D};
    pg8::gemm_phase<pg8::EpiOutRes<L != 0>, pg8::DenseSched, true, 127 - 6, true>(ldsl, (const char*)WSP(unsigned char, WS_CAT), D / 2, S, E, wid0);
}
template <int L> __device__ __forceinline__ void phase_router(const Args& args, char* ldsg, const int wid0) {
    constexpr int T = L == 0 ? TA : TL; const Geo q = geo(wid0);
    bf16_t* wr_hi = WSP(bf16_t, WS_WR);
    norm2_router(T, WSP(bf16_t, WS_X1), INP(7) + (size_t)L * D, WSP(float, WS_MODS) + (size_t)L * 5 * MODW, WSP(unsigned char, WS_H8), wr_hi + (size_t)L * 64 * D, wr_hi + (size_t)(2 + L) * 64 * D, INP(18) + L * 64,
                 WSP(unsigned, WS_CTL) + CW_CNT + L * 64 * 64, WSP(int, WS_LIST), WSP(float, WS_WTS), WSP(int, WS_SLOTI), ldsg, q.vcu, q.G, q.wid, q.lane);
}
template <int L> __device__ __forceinline__ void moe_tables(const Args& args, LAS unsigned char* ldsl, int NT, int tid) {
    constexpr int T = L == 0 ? TA : TL;
    LAS int* ustart = (LAS int*)(ldsl + MISC_OFF + 64 * 4); LAS int* ecnt = (LAS int*)(ldsl + MISC_OFF + 192 * 4); LAS int* tstart = (LAS int*)(ldsl + MISC_OFF + 320 * 4);
    unsigned* cnt = WSP(unsigned, WS_CTL) + CW_CNT + L * 64 * 64;
    __syncthreads();
    if (tid < 64) {
        const int cn = (int)__hip_atomic_load(cnt + tid * 64, __ATOMIC_RELAXED, __HIP_MEMORY_SCOPE_AGENT); ecnt[tid] = cn; if (tid == 0) ecnt[64] = T;
        const int ntl = (cn + 255) >> 8; int inc = ntl;
#pragma unroll
        for (int o = 1; o < 64; o <<= 1) { const int v = __shfl_up(inc, o); if (tid >= o) inc += v; }
        const int exc = inc - ntl; tstart[tid] = exc; ustart[tid] = exc * NT;
        if (tid == 63) { const int n64 = (T + 255) >> 8; tstart[64] = inc; ustart[64] = inc * NT; tstart[65] = inc + n64; ustart[65] = (inc + n64) * NT; }
    }
    __syncthreads();
}
template <int L, int MODE> __device__ __forceinline__ void phase_moe(const Args& args, LAS unsigned char* ldsl, const int wid0) {
    constexpr int NT = MODE == 0 ? 4 : 8; const Geo q = geo(wid0);
    moe_tables<L>(args, ldsl, NT, q.tid);
    LAS int* ustart = (LAS int*)(ldsl + MISC_OFF + 64 * 4); LAS int* ecnt = (LAS int*)(ldsl + MISC_OFF + 192 * 4); LAS int* tstart = (LAS int*)(ldsl + MISC_OFF + 320 * 4);
    pg8::MoeSched S; S.ustart = ustart; S.ecnt = ecnt; S.tstart = tstart; S.total = ustart[65]; S.G = q.G; S.c = q.vcu; S.NT = NT; S.mode = MODE; S.list = WSP(int, WS_LIST);
    if constexpr (MODE == 0) { S.Bt = (const char*)(WSP(unsigned char, WS_WGU) + (size_t)L * 65 * 1024 * D); S.estepB = (size_t)1024 * D; S.tstepB = (size_t)256 * D;
        pg8::EpiGateUp E{WSP(unsigned char, WS_HID)};
        pg8::gemm_phase<pg8::EpiGateUp, pg8::MoeSched, true, 127 - 6, true>(ldsl, (const char*)WSP(unsigned char, WS_H8), D / 2, S, E, wid0);
    } else { S.Bt = (const char*)(WSP(unsigned char, WS_WDN) + (size_t)L * 65 * D * DEXP); S.estepB = (size_t)D * DEXP; S.tstepB = (size_t)256 * DEXP;
        pg8::EpiDown E{WSP(unsigned char, WS_Y)};
        pg8::gemm_phase<pg8::EpiDown, pg8::MoeSched, true, 127 - 5, true>(ldsl, (const char*)WSP(unsigned char, WS_HID), DEXP / 2, S, E, wid0);
    }
}
template <int L> __device__ __forceinline__ void phase_combine(const Args& args, LAS unsigned char* ldsl, char* ldsg, const int wid0) {
    constexpr int T = L == 0 ? TA : TL; const Geo q = geo(wid0);
    moe_tables<L>(args, ldsl, 1, q.tid);
    float* mods = WSP(float, WS_MODS);
    combine_rows(T, WSP(bf16_t, WS_X1), WSP(unsigned char, WS_Y), WSP(float, WS_WTS), WSP(int, WS_SLOTI), (const int*)(ldsg + MISC_OFF + 320 * 4), mods + (size_t)L * 5 * MODW, L == 0 ? INP(6) + D : INP(25), mods + (size_t)5 * MODW, WSP(unsigned char, WS_H), L == 0 ? nullptr : OUTP(), q.gw, q.NGW, q.lane);
}

constexpr unsigned Q_A = 2 * 65 * 512 / 16, Q_B = 3 * 65 * 512 / 16, Q_ALL = 2 * 3 * 65 * 512 / 16;
__device__ __forceinline__ int queue_item(unsigned p) {
    if (p < 2u * 65u * 512u) { const unsigned qa = p >> 9; return T_ND + (int)((((qa >> 1) * 3u + (qa & 1u)) << 9) | (p & 511u)); }
    if (p < 3u * 65u * 512u) { const unsigned pb = p - 2u * 65u * 512u; return T_ND + (int)((((pb >> 9) * 3u + 2u) << 9) | (pb & 511u)); }
    return T_ND + (int)p;
}
__device__ __forceinline__ void steal_convert(unsigned* ctl, int seam, unsigned drain_to, volatile LAS unsigned* MISC, const int wid0) {
    const int tid = opaque_tid(wid0), lane = tid & 63, wid = __builtin_amdgcn_readfirstlane(tid >> 6);
    if (MISC[18] != 0u) return;
    if (tid == 0) __hip_atomic_fetch_add(ctl + CW_ARR + seam * 64, 1u, __ATOMIC_RELAXED, __HIP_MEMORY_SCOPE_AGENT);
    unsigned last = 0u;
#define STEAL_CLAIM(stop_, c_) do { __syncthreads(); if (tid == 0) { unsigned st_ = 0u, cc_ = 0u; \
        const bool all_here_ = __hip_atomic_load(ctl + CW_ARR + seam * 64, __ATOMIC_RELAXED, __HIP_MEMORY_SCOPE_AGENT) >= gridDim.x; \
        if (all_here_ && last >= drain_to) st_ = 1u; \
        else { cc_ = __hip_atomic_fetch_add(ctl + CW_Q, 1u, __ATOMIC_RELAXED, __HIP_MEMORY_SCOPE_AGENT); if (cc_ >= Q_ALL) { st_ = 1u; MISC[18] = 1u; } } \
        MISC[16] = st_; MISC[17] = cc_; } \
        __syncthreads(); stop_ = MISC[16]; c_ = MISC[17]; if (!stop_) last = c_ + 1u; } while (0)
#define STEAL_LOAD(c_, t0_, t1_, n0_, n1_, v0_, v1_) do { TDESC(queue_item((c_) * 16u + (unsigned)wid), t0_, n0_); titem_load(t0_, v0_, lane); TDESC(queue_item((c_) * 16u + 8u + (unsigned)wid), t1_, n1_); titem_load(t1_, v1_, lane); } while (0)
    TItem ta0, ta1, tb0, tb1; int na0, na1, nb0, nb1; f32x4 va0[8], va1[8], vb0[8], vb1[8];
    unsigned stop, c;
    STEAL_CLAIM(stop, c);
    if (stop) return;
    STEAL_LOAD(c, ta0, ta1, na0, na1, va0, va1);
    for (;;) {
        STEAL_CLAIM(stop, c);
        if (!stop) STEAL_LOAD(c, tb0, tb1, nb0, nb1, vb0, vb1);
        titem_store(ta0, va0, na0, lane); titem_store(ta1, va1, na1, lane);
        if (stop) break;
        STEAL_CLAIM(stop, c);
        if (!stop) STEAL_LOAD(c, ta0, ta1, na0, na1, va0, va1);
        titem_store(tb0, vb0, nb0, lane); titem_store(tb1, vb1, nb1, lane);
        if (stop) break;
    }
#undef STEAL_CLAIM
#undef STEAL_LOAD
}

__global__ void __launch_bounds__(NWAVES * 64, 2) mega(Args args) {
    extern __shared__ __attribute__((aligned(16))) unsigned char lds_raw[];
    LAS unsigned char* ldsl = (LAS unsigned char*)lds_raw;
    char* ldsg = (char*)lds_raw;
    volatile LAS unsigned* MISC = (volatile LAS unsigned*)(ldsl + MISC_OFF);
    const int wid0 = __builtin_amdgcn_readfirstlane(threadIdx.x >> 6);
    for (int u = threadIdx.x; u < (LDS_BYTES - MISC_OFF) / 4; u += NWAVES * 64) MISC[u] = 0u;
    __syncthreads();
    XcdBarrier bar; bar.bar = WSP(unsigned, WS_CTL) + CW_BAR; bar.x = 0; bar.st = nullptr; bar.wid0 = wid0;
    if (PH_HI() - PH_LO() > 1) bar = xcd_barrier_post(WSP(unsigned, WS_CTL) + CW_BAR, MISC + 8, wid0);
#define SEAM(k) do { if (IN(k) && IN((k) + 1)) { if ((k) <= 15) steal_convert(WSP(unsigned, WS_CTL), (k), (k) == 7 ? Q_A : (k) == 8 ? Q_B : (k) == 15 ? Q_ALL : 0u, MISC, wid0); xcd_barrier(bar); } } while (0)

    if (SITE(0) && IN(0)) REP(0) phase_prologue(args, ldsl, ldsg, wid0);
    SEAM(0);
    if (SITE(1) && IN(1)) { const Geo q = geo(wid0); norm_mod_rows(INP(0), INP(2), TA, INP(6), WSP(float, WS_MODS), 0, 1, WSP(unsigned char, WS_H), q.gw, q.NGW, q.lane); }
    SEAM(1);
    if (SITE(2) && IN(2)) REP(2) phase_inproj<0>(args, ldsl, wid0);
    SEAM(2);
    if (SITE(3) && IN(3)) REP(3) {
        const Geo q = geo(wid0); const bf16_t* PE = WSP(bf16_t, WS_PE); unsigned char* CAT = WSP(unsigned char, WS_CAT);
        { const float* lbl = INP(10); bf16_t* UB = WSP(bf16_t, WS_U); float* DEC = WSP(float, WS_DEC);
          for (int it = q.vcu; it < NBATCH * 8 * NCHK; it += q.G) { const int ci = it % NCHK, h = (it / NCHK) & 7, b = it / (NCHK * 8); hgrn_a_item(ldsg, PE, lbl, UB, DEC, b, h, ci, wid0); } }
        __syncthreads();
        { const float* sink = INP(12);
          for (int it = (q.vcu + q.G / 2) % q.G; it < 544; it += q.G) {
            if (it < 512) win_attn_item2(ldsg, PE, CAT, sink, it >> 7, (it >> 6) & 1, it & 63, false, wid0);
            else { const int r = it - 512; win_attn_item2(ldsg, PE, CAT, sink, r >> 3, (r >> 2) & 1, r & 3, true, wid0); } } }
    }
    SEAM(3);
    if (SITE(4) && IN(4)) REP(4) hgrn_b_phase(WSP(bf16_t, WS_U), WSP(float, WS_DEC), WSP(bf16_t, WS_S), wid0);
    SEAM(4);
    if (SITE(5) && IN(5)) REP(5) { const Geo q = geo(wid0); const bf16_t* PE = WSP(bf16_t, WS_PE); unsigned char* CAT = WSP(unsigned char, WS_CAT); const float* lbl = INP(10); const bf16_t* SB = WSP(bf16_t, WS_S); const float* gh = INP(11);
        for (int it = q.vcu; it < NBATCH * 8 * NCHK; it += q.G) { const int ci = it % NCHK, h = (it / NCHK) & 7, b = it / (NCHK * 8); hgrn_c_item(ldsg, PE, lbl, SB, gh, CAT, b, h, ci, wid0); } }
    SEAM(5);
    if (SITE(8) && IN(6)) REP(6) phase_outproj<0>(args, ldsl, wid0);
    SEAM(6);
    if (SITE(9) && IN(7)) phase_router<0>(args, ldsg, wid0);
    SEAM(7);
    if (SITE(10) && IN(8)) REP(8) phase_moe<0, 0>(args, ldsl, wid0);
    SEAM(8);
    if (SITE(11) && IN(9)) REP(9) phase_moe<0, 1>(args, ldsl, wid0);
    SEAM(9);
    if (SITE(12) && IN(10)) phase_combine<0>(args, ldsl, ldsg, wid0);
    SEAM(10);
    if (SITE(2) && IN(11)) REP(11) phase_inproj<1>(args, ldsl, wid0);
    SEAM(11);
    if (SITE(6) && IN(12)) REP(12) { const Geo q = geo(wid0); post_odd(WSP(bf16_t, WS_PO), INP(16), WSP(float, WS_TAB) + 2048, WSP(unsigned char, WS_KALL), WSP(unsigned char, WS_VALL), ldsg, q.vcu, q.G, q.gw, q.NGW, q.tid, q.lane); }
    SEAM(12);
    if (SITE(7) && IN(13)) REP(13) { const Geo q = geo(wid0); const bf16_t* PO = WSP(bf16_t, WS_PO); const float* gqn = INP(15); const float* tabo = WSP(float, WS_TAB) + 2048; const unsigned char* KALL = WSP(unsigned char, WS_KALL); const unsigned char* VALL = WSP(unsigned char, WS_VALL); unsigned char* CAT = WSP(unsigned char, WS_CAT);
        for (int it = q.vcu; it < 1024; it += q.G) { const int gq = it & 3, qb = (it >> 2) & 15, kvh = (it >> 6) & 3, b = it >> 8, h = kvh * 4 + gq;
            ga::attn_dense_body(PO + ((size_t)(b * SEQ + qb * 256)) * ODD_IN + h * 128, gqn, tabo, qb * 256, KALL + (size_t)((b * 4 + kvh) * 68) * 8192, VALL + (size_t)((b * 4 + kvh) * 68) * 8192,
                                CAT + ((size_t)(b * SEQ + qb * 256)) * D + h * 128, CTXL + SEQ, ldsg, wid0); } }
    SEAM(13);
    if (SITE(8) && IN(14)) phase_outproj<1>(args, ldsl, wid0);
    SEAM(14);
    if (SITE(9) && IN(15)) phase_router<1>(args, ldsg, wid0);
    SEAM(15);
    if (SITE(10) && IN(16)) REP(16) phase_moe<1, 0>(args, ldsl, wid0);
    SEAM(16);
    if (SITE(11) && IN(17)) REP(17) phase_moe<1, 1>(args, ldsl, wid0);
    SEAM(17);
    if (SITE(12) && IN(18)) phase_combine<1>(args, ldsl, ldsg, wid0);
    if (IN(21)) {
        const Geo q = geo(wid0); const bf16_t* buf = WSP(bf16_t, DBG_BUF_OFF); float* outp = OUTP();
        for (size_t i = (size_t)q.bx * 512 + q.tid; i < (size_t)TL * D; i += (size_t)q.G * 512) { const size_t r = i / D, c = i % D; float v = (c < DBG_BUF_NC && r < DBG_NR) ? (DBG_F32 ? ((const float*)buf)[r * DBG_BUF_LD + DBG_BUF_COL0 + c] : bf2f(buf[r * DBG_BUF_LD + DBG_BUF_COL0 + c])) : 0.f; if (DBG_NANCHK == 1) v = (v == v && fabsf(v) < 1e30f) ? 0.f : 1.f; if (DBG_NANCHK == 2) v = (v == v) ? fminf(fmaxf(v, -1e3f), 1e3f) : 1e3f; outp[i] = v; }
    }
    if (IN(19) || IN(20)) {
        const Geo q = geo(wid0); const float* src = INP(0); const float* gf = INP(25); float* outp = OUTP();
        for (int r = q.gw; r < TL; r += q.NGW) { f32x4 v[8]; float ss = 0.f;
#pragma unroll
            for (int j = 0; j < 8; ++j) { v[j] = *(const f32x4*)(src + (size_t)r * D + 4 * q.lane + 256 * j); ss += (v[j][0] * v[j][0] + v[j][1] * v[j][1]) + (v[j][2] * v[j][2] + v[j][3] * v[j][3]); }
            const float rstd = rsqrtf(wave_sum(ss) * (1.0f / D) + EPS);
#pragma unroll
            for (int j = 0; j < 8; ++j) *(f32x4*)(outp + (size_t)r * D + 4 * q.lane + 256 * j) = v[j] * rstd * *(const f32x4*)(gf + 4 * q.lane + 256 * j); }
    }
#undef SEAM
}

extern "C" void kernel_launch(void* const* d_in, const int* in_sizes, int n_in, void* d_out, int out_size, void* d_ws, size_t ws_size, hipStream_t stream) {
    static int grid = 0;
    if (grid == 0) {
        if (n_in != 26 || in_sizes[0] != TL * D || out_size != TL * D || ws_size < WS_END) { fprintf(stderr, "kernel_launch: unexpected shapes (n_in %d, in0 %d, out %d, ws %zu < %zu)\n", n_in, n_in > 0 ? in_sizes[0] : -1, out_size, ws_size, (size_t)WS_END); grid = -1; return; }
        int dev = 0, cus = 0, per_cu = 0;
        if (hipGetDevice(&dev) != hipSuccess || hipDeviceGetAttribute(&cus, hipDeviceAttributeMultiprocessorCount, dev) != hipSuccess) { grid = -1; return; }
        if (hipFuncSetAttribute((const void*)mega, hipFuncAttributeMaxDynamicSharedMemorySize, LDS_BYTES) != hipSuccess) { fprintf(stderr, "kernel_launch: hipFuncSetAttribute failed\n"); grid = -1; return; }
        if (hipOccupancyMaxActiveBlocksPerMultiprocessor(&per_cu, (const void*)mega, NWAVES * 64, LDS_BYTES) != hipSuccess || per_cu < 1) fprintf(stderr, "kernel_launch: occupancy query reports %d\n", per_cu);
        (void)hipGetLastError();
        grid = cus;
    }
    if (grid < 0) return;
    if (hipMemsetAsync((char*)d_ws + WS_CTL, 0, CTL_ZERO_BYTES, stream) != hipSuccess) return;
    Args a{};
    for (int i = 0; i < 26; ++i) a.in[i] = (const float*)d_in[i];
    a.out = (float*)d_out; a.ws = (unsigned char*)d_ws;
#if N_LAUNCH_MODE == 1
    a.ph_lo = 0; a.ph_hi = NPHASE;
    hipLaunchKernelGGL(mega, dim3(grid), dim3(NWAVES * 64), LDS_BYTES, stream, a);
#else
    for (int p = 0; p < DBG_NPH; ++p) { a.ph_lo = p; a.ph_hi = p + 1; hipLaunchKernelGGL(mega, dim3(grid), dim3(NWAVES * 64), LDS_BYTES, stream, a); }
    if (DBG_FIN) { a.ph_lo = DBG_FIN; a.ph_hi = DBG_FIN + 1; hipLaunchKernelGGL(mega, dim3(grid), dim3(NWAVES * 64), LDS_BYTES, stream, a); }
#endif
    const hipError_t le = hipPeekAtLastError();
    if (le != hipSuccess) fprintf(stderr, "kernel_launch: launch failed: %s\n", hipGetErrorName(le));
}
```
